# Optimizing an MI355X kernel written in HIP

```python
import jax, jax.numpy as jnp
from jax import lax
import numpy as np

D_MODEL = 1024
BATCH = 16
SEQ = 2048
DEPTH = 1

CHUNK = 64
ROPE_THETA = 10000.0
NORM_EPS = 1e-6

MLA_HEADS = 8
MLA_Q_LORA = 384
MLA_KV_LORA = 256
MLA_NOPE = 128
MLA_ROPE = 64
MLA_V = 128
MLA_QK = MLA_NOPE + MLA_ROPE
MLA_Q_BLOCK = 128

DSA_HEADS = 8
DSA_HEAD_DIM = 128
IDX_HEADS = 8
IDX_HEAD_DIM = 64
IDX_ROPE = 32
DSA_TOPK_MAX = 256
DSA_Q_BLOCK = 16

N_BRANCHES = 2

IN_SPLIT_SIZES = (
    MLA_Q_LORA,
    MLA_KV_LORA,
    MLA_ROPE,
    3 * DSA_HEADS * DSA_HEAD_DIM,
    IDX_HEADS * IDX_HEAD_DIM,
    IDX_HEAD_DIM,
    IDX_HEADS,
    N_BRANCHES * D_MODEL,
)
D_IN = (MLA_Q_LORA + MLA_KV_LORA + MLA_ROPE + 3 * DSA_HEADS * DSA_HEAD_DIM
        + IDX_HEADS * IDX_HEAD_DIM + IDX_HEAD_DIM + IDX_HEADS + N_BRANCHES * D_MODEL)

N_EXPERTS = 32
MOE_TOP_K = 4
D_EXPERT = 1024
SWIGLU_LIMIT = 7.0
SWIGLU_ALPHA = 1.702
MOE_BLOCK = 128

kernel_name = "hybrid_mla_dsa_gated_moe_block"


def rms_norm(x, g):
    xf = x.astype(jnp.float32)
    y = xf * lax.rsqrt(jnp.mean(xf * xf, axis=-1, keepdims=True) + NORM_EPS)
    return (y * g.astype(jnp.float32)).astype(x.dtype)


def rope(x, pos, rot_dim):
    half = rot_dim // 2
    inv_freq = ROPE_THETA ** (-jnp.arange(half, dtype=jnp.float32) / half)
    ang = pos.astype(jnp.float32)[:, None] * inv_freq[None, :]
    cos = jnp.cos(ang)[:, None, :].astype(x.dtype)
    sin = jnp.sin(ang)[:, None, :].astype(x.dtype)
    x1, x2, xp = x[..., :half], x[..., half:rot_dim], x[..., rot_dim:]
    return jnp.concatenate([x1 * cos - x2 * sin, x2 * cos + x1 * sin, xp], axis=-1)


def split_cols(proj):
    points, acc = [], 0
    for s in IN_SPLIT_SIZES[:-1]:
        acc += s
        points.append(acc)
    return jnp.split(proj, points, axis=-1)


def mla_attention(c_q, c_kv, k_r, q_lora_g, kv_lora_g, w_uq, w_uk, w_uv, pos):
    B, S, _ = c_q.shape
    cq = rms_norm(c_q, q_lora_g)
    ckv = rms_norm(c_kv, kv_lora_g)
    q = (cq @ w_uq).reshape(B, S, MLA_HEADS, MLA_QK)
    q = jnp.concatenate([q[..., :MLA_NOPE], rope(q[..., MLA_NOPE:], pos, MLA_ROPE)], axis=-1)
    q = q * (MLA_QK ** -0.5)
    k_nope = (ckv @ w_uk).reshape(B, S, MLA_HEADS, MLA_NOPE)
    k_rope = rope(k_r[:, :, None, :], pos, MLA_ROPE)
    k = jnp.concatenate([k_nope, jnp.broadcast_to(k_rope, (B, S, MLA_HEADS, MLA_ROPE))], axis=-1)
    v = (ckv @ w_uv).reshape(B, S, MLA_HEADS, MLA_V)
    key_chunk = pos // CHUNK
    n_blocks = S // MLA_Q_BLOCK

    def block(i):
        q_blk = lax.dynamic_slice_in_dim(q, i * MLA_Q_BLOCK, MLA_Q_BLOCK, axis=1)
        q_chunk = lax.dynamic_slice_in_dim(key_chunk, i * MLA_Q_BLOCK, MLA_Q_BLOCK)
        s = jnp.einsum('bqhd,bkhd->bhqk', q_blk, k).astype(jnp.float32)
        mask = key_chunk[None, :] <= q_chunk[:, None]
        s = jnp.where(mask[None, None], s, -jnp.inf)
        p = jax.nn.softmax(s, axis=-1).astype(v.dtype)
        return jnp.einsum('bhqk,bkhd->bqhd', p, v)

    o = lax.map(block, jnp.arange(n_blocks))
    return o.transpose(1, 0, 2, 3, 4).reshape(B, S, MLA_HEADS * MLA_V)


def dsa_attention(qkv, q_idx, k_idx, w_idx, pos, top_k):
    B, S, _ = qkv.shape
    q, k, v = jnp.split(qkv.reshape(B, S, 3, DSA_HEADS, DSA_HEAD_DIM), 3, axis=2)
    q, k, v = q[:, :, 0], k[:, :, 0], v[:, :, 0]
    q = rope(q, pos, DSA_HEAD_DIM) * (DSA_HEAD_DIM ** -0.5)
    k = rope(k, pos, DSA_HEAD_DIM)
    qi = rope(q_idx.reshape(B, S, IDX_HEADS, IDX_HEAD_DIM), pos, IDX_ROPE) * (IDX_HEAD_DIM ** -0.5)
    ki = rope(k_idx[:, :, None, :], pos, IDX_ROPE)[:, :, 0, :]
    wi = w_idx * (IDX_HEADS ** -0.5)
    key_chunk = pos // CHUNK
    n_blocks = S // DSA_Q_BLOCK
    gather_rows = jax.vmap(lambda kb, ib: kb[ib])

    def block(i):
        start = i * DSA_Q_BLOCK
        qi_b = lax.dynamic_slice_in_dim(qi, start, DSA_Q_BLOCK, axis=1)
        wi_b = lax.dynamic_slice_in_dim(wi, start, DSA_Q_BLOCK, axis=1)
        q_b = lax.dynamic_slice_in_dim(q, start, DSA_Q_BLOCK, axis=1)
        q_chunk = lax.dynamic_slice_in_dim(key_chunk, start, DSA_Q_BLOCK)
        raw = jnp.einsum('bqhd,bsd->bqhs', qi_b, ki)
        score = jnp.einsum('bqh,bqhs->bqs', wi_b, jax.nn.relu(raw)).astype(jnp.float32)
        admissible = key_chunk[None, :] <= q_chunk[:, None]
        score = jnp.where(admissible[None], score, -jnp.inf)
        _, sel = lax.top_k(score, top_k)
        valid = (sel // CHUNK) <= q_chunk[None, :, None]
        k_sel = gather_rows(k, sel)
        v_sel = gather_rows(v, sel)
        s = jnp.einsum('bqhd,bqkhd->bqhk', q_b, k_sel).astype(jnp.float32)
        s = jnp.where(valid[:, :, None, :], s, -jnp.inf)
        p = jax.nn.softmax(s, axis=-1).astype(v.dtype)
        return jnp.einsum('bqhk,bqkhd->bqhd', p, v_sel)

    o = lax.map(block, jnp.arange(n_blocks))
    return o.transpose(1, 0, 2, 3, 4).reshape(B, S, DSA_HEADS * DSA_HEAD_DIM)


def moe_ffn(xn, w_router, b_router, w_gate_up, b_gate_up, w_down, b_down):
    B, S, D = xn.shape
    T = B * S
    xt = xn.reshape(T, D)
    logits = (xt @ w_router + b_router).astype(jnp.float32)
    top_vals, top_idx = lax.top_k(logits, MOE_TOP_K)
    gates = jax.nn.softmax(top_vals, axis=-1)
    A = T * MOE_TOP_K
    e_flat = top_idx.reshape(A)
    tok_flat = jnp.arange(A, dtype=jnp.int32) // MOE_TOP_K
    g_flat = gates.reshape(A)
    order = jnp.argsort(e_flat)
    e_s, tok_s, g_s = e_flat[order], tok_flat[order], g_flat[order]
    counts = jax.ops.segment_sum(jnp.ones((A,), jnp.int32), e_flat, num_segments=N_EXPERTS)
    offsets = jnp.cumsum(counts) - counts
    padded = ((counts + MOE_BLOCK - 1) // MOE_BLOCK) * MOE_BLOCK
    pad_end = jnp.cumsum(padded)
    pad_off = pad_end - padded
    dest = pad_off[e_s] + jnp.arange(A, dtype=jnp.int32) - offsets[e_s]
    P = A + N_EXPERTS * MOE_BLOCK
    n_blocks = P // MOE_BLOCK
    tok_buf = jnp.full((P,), T, jnp.int32).at[dest].set(tok_s)
    g_buf = jnp.zeros((P,), jnp.float32).at[dest].set(g_s)
    blk_start = jnp.arange(n_blocks, dtype=jnp.int32) * MOE_BLOCK
    blk_expert = jnp.minimum(jnp.searchsorted(pad_end, blk_start, side='right'), N_EXPERTS - 1)
    x_pad = jnp.concatenate([xt, jnp.zeros((1, D), xt.dtype)], axis=0)

    def expert_block(args):
        toks, e = args
        xb = x_pad[toks]
        h = xb @ w_gate_up[e] + b_gate_up[e]
        gate = jnp.minimum(h[:, :D_EXPERT], SWIGLU_LIMIT)
        lin = jnp.clip(h[:, D_EXPERT:], -SWIGLU_LIMIT, SWIGLU_LIMIT)
        glu = gate * jax.nn.sigmoid(SWIGLU_ALPHA * gate)
        return ((lin + 1.0) * glu) @ w_down[e] + b_down[e]

    y = lax.map(expert_block, (tok_buf.reshape(n_blocks, MOE_BLOCK), blk_expert))
    y = y.reshape(P, D) * g_buf[:, None].astype(y.dtype)
    out = jnp.zeros((T + 1, D), y.dtype).at[tok_buf].add(y)[:T]
    return out.reshape(B, S, D)


def setup_inputs(seed: int = 0) -> dict:
    key = jax.random.key(seed)
    ks = jax.random.split(key, 20)

    def w(k, shape, fan_in):
        return jax.random.normal(k, shape, jnp.float32) * (fan_in ** -0.5)

    def gain(k, shape):
        return 1.0 + 0.05 * jax.random.normal(k, shape, jnp.float32)

    def bias(k, shape, scale=0.01):
        return scale * jax.random.normal(k, shape, jnp.float32)

    L = DEPTH
    return {
        "x": jax.random.normal(ks[0], (BATCH, SEQ, D_MODEL), jnp.float32),
        "norm_attn_g": gain(ks[1], (L, D_MODEL)),
        "w_in": w(ks[2], (L, D_MODEL, D_IN), D_MODEL),
        "q_lora_g": gain(ks[3], (L, MLA_Q_LORA)),
        "kv_lora_g": gain(ks[4], (L, MLA_KV_LORA)),
        "w_uq": w(ks[5], (L, MLA_Q_LORA, MLA_HEADS * MLA_QK), MLA_Q_LORA),
        "w_uk": w(ks[6], (L, MLA_KV_LORA, MLA_HEADS * MLA_NOPE), MLA_KV_LORA),
        "w_uv": w(ks[7], (L, MLA_KV_LORA, MLA_HEADS * MLA_V), MLA_KV_LORA),
        "w_o_mla": w(ks[8], (L, MLA_HEADS * MLA_V, D_MODEL), MLA_HEADS * MLA_V),
        "w_o_dsa": w(ks[9], (L, DSA_HEADS * DSA_HEAD_DIM, D_MODEL), DSA_HEADS * DSA_HEAD_DIM),
        "b_gate": bias(ks[10], (L, N_BRANCHES * D_MODEL), 0.1),
        "w_out": w(ks[11], (L, D_MODEL, D_MODEL), D_MODEL),
        "norm_ffn_g": gain(ks[12], (L, D_MODEL)),
        "w_router": w(ks[13], (L, D_MODEL, N_EXPERTS), D_MODEL),
        "b_router": bias(ks[14], (L, N_EXPERTS)),
        "w_gate_up": w(ks[15], (L, N_EXPERTS, D_MODEL, 2 * D_EXPERT), D_MODEL),
        "b_gate_up": bias(ks[16], (L, N_EXPERTS, 2 * D_EXPERT)),
        "w_down": w(ks[17], (L, N_EXPERTS, D_EXPERT, D_MODEL), D_EXPERT),
        "b_down": bias(ks[18], (L, N_EXPERTS, D_MODEL)),
        "norm_final_g": gain(ks[19], (D_MODEL,)),
    }


def reference(x, norm_attn_g, w_in, q_lora_g, kv_lora_g, w_uq, w_uk, w_uv, w_o_mla, w_o_dsa,
              b_gate, w_out, norm_ffn_g, w_router, b_router, w_gate_up, b_gate_up, w_down,
              b_down, norm_final_g):
    B, S, D = x.shape
    pos = jnp.arange(S, dtype=jnp.int32)
    top_k = min(DSA_TOPK_MAX, S // 4)
    for l in range(DEPTH):
        h = rms_norm(x, norm_attn_g[l])
        proj = h @ w_in[l]
        c_q, c_kv, k_r, qkv, q_idx, k_idx, w_idx, gate_cols = split_cols(proj)
        y_a = mla_attention(c_q, c_kv, k_r, q_lora_g[l], kv_lora_g[l],
                            w_uq[l], w_uk[l], w_uv[l], pos) @ w_o_mla[l]
        y_b = dsa_attention(qkv, q_idx, k_idx, w_idx, pos, top_k) @ w_o_dsa[l]
        g = jax.nn.sigmoid(gate_cols + b_gate[l]).reshape(B, S, N_BRANCHES, D)
        merged = g[:, :, 0, :] * y_a + g[:, :, 1, :] * y_b
        x = x + merged @ w_out[l]
        hn = rms_norm(x, norm_ffn_g[l])
        x = x + moe_ffn(hn, w_router[l], b_router[l], w_gate_up[l], b_gate_up[l],
                        w_down[l], b_down[l])
    return rms_norm(x, norm_final_g)
```

```cpp
#include <hip/hip_runtime.h>
#include <cstdio>
#include <cstdint>
#include <cmath>
#ifndef REPEAT_PHASE
#define REPEAT_PHASE -1
#endif
#define REPS(k) for (int rep_ = 0; rep_ < ((REPEAT_PHASE == (k)) ? 2 : 1); ++rep_)
__device__ __forceinline__ int opaque_n(int n) { asm volatile("" : "+s"(n)); return n; }
#define REPS_RT(k) for (int rep_ = 0, nrep_ = (REPEAT_PHASE == (k)) ? opaque_n(2) : 1; rep_ < nrep_; ++rep_)
namespace pg8 {
#define PG8_LAS __attribute__((address_space(3)))
typedef unsigned short bf16_t;
typedef short bf16x8 __attribute__((ext_vector_type(8)));
typedef float f32x4 __attribute__((ext_vector_type(4)));
typedef float f32x2 __attribute__((ext_vector_type(2)));
typedef unsigned u32x4 __attribute__((ext_vector_type(4)));
typedef unsigned u32x2 __attribute__((ext_vector_type(2)));
constexpr int PG8_TOKL_OFF = 139264 + 2048;
constexpr int BM = 256, BK = 64, HALF = 128, HTB = HALF * BK * 2  , STAGE_BYTES = 8 * HTB, NXCD = 8, WGM = 8;

__host__ __device__ __forceinline__ int lds_byte(int r, int c) { const int st = (r >> 4) * 2 + (c >> 5), rr = r & 15, cc = c & 31, ob = rr * 64 + cc * 2; return st * 1024 + (ob ^ (((ob >> 9) & 1) << 5)); }
__host__ __device__ __forceinline__ void stage_rc(int b, int& R, int& C) { const int st = b / 1024, sb = b % 1024, swz = sb ^ (((sb >> 9) & 1) << 5); R = (st >> 1) * 16 + swz / 64; C = (st & 1) * 32 + (swz % 64) / 2; }
__host__ __device__ __forceinline__ int perm32(int rho) { const int n = rho >> 4, i = rho & 15; return 8 * (i >> 2) + 4 * n + (i & 3); }

struct Unit { int pm, pn, e, rows, row_off; const char* A; const char* B; const int* toks; };

struct TileOrder {
    int nM, nN, nwg, G, c;
    __device__ void init(int nM_, int nN_, int G_, int c_) { nM = nM_; nN = nN_; nwg = nM * nN; G = G_; c = c_; }
    __device__ bool tile(int i, int& pm, int& pn) const {
        const long L = (long)i * G + c; if (L >= nwg) return false;
        int wgid = (int)L; { const int q = nwg / NXCD, r = nwg % NXCD, xcd = wgid % NXCD, off = wgid / NXCD; wgid = (xcd < r ? xcd * (q + 1) : r * (q + 1) + (xcd - r) * q) + off; }
        const int nig = WGM * nN, gid = wgid / nig, fm = gid * WGM, gsz = (nM - fm) < WGM ? (nM - fm) : WGM;
        pm = fm + ((wgid % nig) % gsz); pn = (wgid % nig) / gsz; return true;
    }
};
struct DenseOrder {
    TileOrder t; const char* A; const char* B; int lda, K, esz; unsigned sel; bool lin;
    __device__ void init(const void* A_, int lda_, const void* B_, int K_, int M, int N, int G, int c, int esz_ = 2, unsigned sel_ = 0u, bool lin_ = false) { lin = lin_;
        t.init(M / BM, sel_ ? __builtin_popcount(sel_) : N / BM, G, c); A = (const char*)A_; B = (const char*)B_; lda = lda_; K = K_; esz = esz_; sel = sel_; }
    __device__ bool next(int i, Unit& u) const {
        int pm, pn; if (!t.tile(i, pm, pn)) return false;
        if (sel) { int left = pn, p = 0;
#pragma unroll 1
            for (int k = 0; k < 32; ++k) { if ((sel >> k) & 1u) { if (left == 0) p = k; --left; } }
            pn = p; }
        u.pm = pm; u.pn = pn; u.e = 0; u.rows = BM; u.row_off = pm * BM; u.A = lin ? A : A + (size_t)pm * BM * lda * esz; u.B = B + (size_t)pn * BM * K * esz; u.toks = nullptr; return true;
    }
};
struct MoeOrder {
    const PG8_LAS int* cum; const PG8_LAS int* cnt; const PG8_LAS int* off; int nN, G, c, K; const char* A; const char* B; size_t bstride; const int* toks; bool gather; int esz;
    __device__ bool next(int i, Unit& u) const {
        const int L0 = i * G + c; const int total = cum[32] * nN; if (L0 >= total) return false;
        int L = L0;
        if ((G & 7) == 0) { const int q = total >> 3, r = total & 7, xcd = L0 & 7, o = L0 >> 3; L = (xcd < r ? xcd * (q + 1) : r * (q + 1) + (xcd - r) * q) + o; }
        const int lk = (int)(threadIdx.x & 31u);
        const int e = __builtin_amdgcn_readfirstlane(__popcll(__ballot(L >= cum[lk + 1] * nN) & 0xffffffffull));
        const int te = cum[e + 1] - cum[e], r = L - cum[e] * nN, MB = 32 / nN;
        const int blk = r / (MB * nN), rr = r - blk * (MB * nN), rows = min(MB, te - blk * MB), pn = rr / rows, mt = blk * MB + (rr - pn * rows);
        u.pm = mt; u.pn = pn; u.e = e; u.rows = min(BM, cnt[e] - mt * BM); u.row_off = off[e] + mt * BM;
        u.B = B + (size_t)e * bstride + (size_t)pn * BM * K * esz;
        if (gather) { u.A = A; u.toks = toks + (size_t)e * 32768 + mt * BM; } else { u.A = A; u.toks = nullptr; }
        return true;
    }
};

__device__ __forceinline__ unsigned cvt_pk_bf16(float lo, float hi) { unsigned r; asm volatile("v_cvt_pk_bf16_f32 %0, %1, %2" : "=v"(r) : "v"(lo), "v"(hi)); return r; }

typedef int v8i32 __attribute__((ext_vector_type(8)));
typedef int v4i32 __attribute__((ext_vector_type(4)));
template <class Epi, class Sched, bool GATHER, bool F8 = false>
__device__ __forceinline__ void gemm_phase(PG8_LAS unsigned char* lds, const int K, const int lda, const Sched& S, const Epi& E, const bool noepi = false, const int SCL_B = 0x79797979  , const int SCL_A = 0x7d7d7d7d  ) {
    int tid_ = threadIdx.x; asm volatile("" : "+v"(tid_));
    const int tid = tid_, wid = __builtin_amdgcn_readfirstlane(tid >> 6), lane = tid & 63, wr = wid >> 2, wc = wid & 3, fr = lane & 15, fq = lane >> 4;
    constexpr int ESZ = F8 ? 1 : 2;
    int nt_ = (K * ESZ) / 128; asm volatile("" : "+s"(nt_)); const int nt = nt_;
    unsigned voffA[2], voffB[2];
#pragma unroll
    for (int i = 0; i < 2; ++i) { int R, C; stage_rc(tid * 16 + i * 8192, R, C); const int Rb = Epi::PERM ? ((R & ~31) + perm32(R & 31)) : R;
        voffA[i] = (unsigned)(R * lda * ESZ + C * 2); voffB[i] = (unsigned)(Rb * K * ESZ + C * 2); }
    const size_t kstep = (size_t)(BK * 2);
    const size_t hstepA = GATHER ? 0 : (size_t)HALF * lda * ESZ, hstepB = (size_t)HALF * K * ESZ;
    const unsigned ldsw = (unsigned)wid * 1024u;
    const int aoff = lds_byte(wr * 64 + fr, F8 ? fq * 16 : fq * 8), boff = lds_byte(wc * 32 + fr, F8 ? fq * 16 : fq * 8);
    constexpr int aoff1 = F8 ? 16 : 1024, boff1 = F8 ? 16 : 1024;
    unsigned vgC[2][2];
    const PG8_LAS int* tokl = (const PG8_LAS int*)(lds + PG8_TOKL_OFF);
#define PG8_SA(b, h) (((b) * 2 + (h)) * HTB)
#define PG8_SB(b, h) ((4 + (b) * 2 + (h)) * HTB)
#define PG8_STAGE(bufoff, gbase, voff) do { _Pragma("unroll") for (int _i = 0; _i < 2; ++_i) \
        __builtin_amdgcn_global_load_lds((const unsigned*)((const char*)(gbase) + (voff)[_i]), (PG8_LAS unsigned*)(lds + (bufoff) + ldsw + _i * 8192), 16, 0, 0); } while (0)
#define PG8_STAGEA(bufoff, gbase, h) do { if constexpr (GATHER) { PG8_STAGE(bufoff, gbase, vgC[h]); } else { PG8_STAGE(bufoff, (gbase) + (h) * hstepA, voffA); } } while (0)
#define PG8_GOFF(dst, u) do { _Pragma("unroll") for (int _h = 0; _h < 2; ++_h) _Pragma("unroll") for (int _i = 0; _i < 2; ++_i) { int _R, _C; stage_rc(tid * 16 + _i * 8192, _R, _C); const int _r = _h * HALF + _R; \
        const int _t = (u).toks ? (u).toks[min(_r, (u).rows - 1)] : (u).row_off + _r; dst[_h][_i] = (unsigned)(_t * lda * ESZ + _C * 2); } } while (0)
#define PG8_LD8(base) (__builtin_shufflevector(*(const PG8_LAS v4i32*)(base), *(const PG8_LAS v4i32*)((base) + aoff1_or_boff1), 0, 1, 2, 3, 4, 5, 6, 7))
#define PG8_LDA(dst, b, h) do { if constexpr (F8) { _Pragma("unroll") for (int m = 0; m < 4; ++m) { const int aoff1_or_boff1 = aoff1; dst##8[m] = PG8_LD8(lds + PG8_SA(b, h) + aoff + m * 2048); } } \
        else { _Pragma("unroll") for (int m = 0; m < 4; ++m) _Pragma("unroll") for (int k = 0; k < 2; ++k) dst[m][k] = *(const PG8_LAS bf16x8*)(lds + PG8_SA(b, h) + aoff + m * 2048 + k * 1024); } } while (0)
#define PG8_LDB(dst, b, h) do { if constexpr (F8) { _Pragma("unroll") for (int n = 0; n < 2; ++n) { const int aoff1_or_boff1 = boff1; dst##8[n] = PG8_LD8(lds + PG8_SB(b, h) + boff + n * 2048); } } \
        else { _Pragma("unroll") for (int n = 0; n < 2; ++n) _Pragma("unroll") for (int k = 0; k < 2; ++k) dst[n][k] = *(const PG8_LAS bf16x8*)(lds + PG8_SB(b, h) + boff + n * 2048 + k * 1024); } } while (0)
#define PG8_MMA(ai, bj, At, Bt) do { __builtin_amdgcn_s_setprio(1); _Pragma("unroll") for (int m = 0; m < 4; ++m) _Pragma("unroll") for (int n = 0; n < 2; ++n) { if constexpr (F8) { \
        acc[ai][bj][m][n] = __builtin_amdgcn_mfma_scale_f32_16x16x128_f8f6f4(Bt##8[n], At##8[m], acc[ai][bj][m][n], 0, 0, 0, SCL_B, 0, SCL_A); } else { _Pragma("unroll") for (int k = 0; k < 2; ++k) \
        acc[ai][bj][m][n] = __builtin_amdgcn_mfma_f32_16x16x32_bf16(Bt[n][k], At[m][k], acc[ai][bj][m][n], 0, 0, 0); } } __builtin_amdgcn_s_setprio(0); } while (0)
#define PG8_WAIT_V(n) asm volatile("s_waitcnt vmcnt(" #n ")" ::: "memory")
#define PG8_WAIT_L(n) asm volatile("s_waitcnt lgkmcnt(" #n ")" ::: "memory")
#define PG8_BAR __builtin_amdgcn_s_barrier()
#define PG8_SCHED __builtin_amdgcn_sched_barrier(0)
    Unit cur, nxt; int ui = 0;
    if (!S.next(0, cur)) return;
#ifdef STAGGER
    { const int dl = ((int)blockIdx.x >> 3) & 3; for (int k = 0; k < dl * STAGGER; ++k) __builtin_amdgcn_s_sleep(127); }
#endif
    f32x4 acc[2][2][4][2]; f32x4 binit[2][2];
    E.bias(cur, wr, wc, fq, binit);
#pragma unroll
    for (int a = 0; a < 2; ++a)
#pragma unroll
        for (int b = 0; b < 2; ++b)
#pragma unroll
            for (int m = 0; m < 4; ++m)
#pragma unroll
                for (int n = 0; n < 2; ++n) acc[a][b][m][n] = binit[b][n];
    bf16x8 At[4][2], B0[2][2], B1[2][2]; v8i32 At8[4], B08[2], B18[2];
    const char* cA = cur.A; const char* cB = cur.B;
    if constexpr (GATHER) { PG8_GOFF(vgC, cur); }
    PG8_STAGE(PG8_SB(0, 0), cB, voffB); PG8_STAGE(PG8_SB(0, 1), cB + hstepB, voffB); PG8_STAGEA(PG8_SA(0, 0), cA, 0); PG8_STAGEA(PG8_SA(0, 1), cA, 1);
    if (wr == 1) PG8_BAR;
    PG8_WAIT_V(2); PG8_BAR;
    PG8_STAGE(PG8_SB(1, 0), cB + kstep, voffB); PG8_STAGEA(PG8_SA(1, 0), cA + kstep, 0); PG8_STAGE(PG8_SB(1, 1), cB + hstepB + kstep, voffB);
    PG8_WAIT_V(6); PG8_BAR;
    for (;;) {
        const bool has_next = S.next(ui + 1, nxt);
        if constexpr (GATHER) { if (has_next && nxt.toks && tid < BM)
            __builtin_amdgcn_global_load_lds((const unsigned*)(nxt.toks + min(tid, nxt.rows - 1)), (PG8_LAS unsigned*)(lds + PG8_TOKL_OFF + (unsigned)wid * 256u), 4, 0, 0); }
        const char* nA = has_next ? nxt.A : cA; const char* nB = has_next ? nxt.B : cB;
#pragma unroll 1
        for (int t = 0; t < nt; t += 2) {
            const bool last = (t == nt - 2);
            const char* a1 = cA + (size_t)(t + 1) * kstep;
            const char* a2 = last ? nA : cA + (size_t)(t + 2) * kstep; const char* b2 = last ? nB : cB + (size_t)(t + 2) * kstep;
            const char* a3 = a2 + kstep; const char* b3 = b2 + kstep;
            PG8_LDB(B0, 0, 0); PG8_LDB(B1, 0, 1); PG8_SCHED; PG8_LDA(At, 0, 0); PG8_STAGEA(PG8_SA(1, 1), a1, 1);
            if constexpr (GATHER) { if (last && has_next) {
                if (nxt.toks) { _Pragma("unroll") for (int _h = 0; _h < 2; ++_h) _Pragma("unroll") for (int _i = 0; _i < 2; ++_i) { int _R, _C; stage_rc(tid * 16 + _i * 8192, _R, _C);
                    vgC[_h][_i] = (unsigned)(tokl[_h * HALF + _R] * lda * ESZ + _C * 2); } }
                else { PG8_GOFF(vgC, nxt); } } }
            PG8_WAIT_V(8); PG8_WAIT_L(0); PG8_BAR; PG8_MMA(0, 0, At, B0); PG8_MMA(0, 1, At, B1); PG8_BAR; PG8_SCHED;
            PG8_LDA(At, 0, 1); PG8_STAGE(PG8_SB(0, 0), b2, voffB); PG8_STAGE(PG8_SB(0, 1), b2 + hstepB, voffB); PG8_STAGEA(PG8_SA(0, 0), a2, 0);
            PG8_WAIT_V(8); PG8_WAIT_L(0); PG8_BAR; PG8_MMA(1, 0, At, B0); PG8_MMA(1, 1, At, B1); PG8_BAR; PG8_SCHED;
            PG8_LDB(B0, 1, 0); PG8_LDB(B1, 1, 1); PG8_SCHED; PG8_LDA(At, 1, 0); PG8_STAGEA(PG8_SA(0, 1), a2, 1);
            PG8_WAIT_V(8); PG8_WAIT_L(0); PG8_BAR; PG8_MMA(0, 0, At, B0); PG8_MMA(0, 1, At, B1); PG8_BAR; PG8_SCHED;
            PG8_LDA(At, 1, 1); PG8_STAGE(PG8_SB(1, 0), b3, voffB); PG8_STAGE(PG8_SB(1, 1), b3 + hstepB, voffB); PG8_STAGEA(PG8_SA(1, 0), a3, 0);
            PG8_WAIT_V(8); PG8_WAIT_L(0); PG8_BAR; PG8_MMA(1, 0, At, B0); PG8_MMA(1, 1, At, B1); PG8_BAR; PG8_SCHED;
        }
        if (wr == 0) PG8_BAR;
        E.bias(has_next ? nxt : cur, wr, wc, fq, binit);
#ifdef PROBE_NOEPI
        if (noepi) {
#pragma unroll
            for (int a = 0; a < 2; ++a)
#pragma unroll
                for (int b = 0; b < 2; ++b)
#pragma unroll
                    for (int m = 0; m < 4; ++m)
#pragma unroll
                        for (int n = 0; n < 2; ++n) asm volatile("" :: "v"(acc[a][b][m][n]));
        } else
#endif
        { int te_ = threadIdx.x; asm volatile("" : "+v"(te_));
          const int we_ = __builtin_amdgcn_readfirstlane(te_ >> 6), le_ = te_ & 63; E(acc, cur, we_ >> 2, we_ & 3, le_ & 15, le_ >> 4); }
        if (!has_next) break;
#pragma unroll
        for (int a = 0; a < 2; ++a)
#pragma unroll
            for (int b = 0; b < 2; ++b)
#pragma unroll
                for (int m = 0; m < 4; ++m)
#pragma unroll
                    for (int n = 0; n < 2; ++n) acc[a][b][m][n] = binit[b][n];
        cur = nxt; cA = nA; cB = nB; ++ui;
        if (wr == 1) PG8_BAR;
    }
    PG8_WAIT_V(0);
    PG8_BAR;
#undef PG8_SA
#undef PG8_SB
#undef PG8_STAGE
#undef PG8_STAGEA
#undef PG8_GOFF
#undef PG8_LDA
#undef PG8_LDB
#undef PG8_MMA
#undef PG8_LD8
#undef PG8_WAIT_V
#undef PG8_WAIT_L
#undef PG8_BAR
#undef PG8_SCHED
}
}
namespace pg8 {
__device__ __forceinline__ float bf_lo(unsigned w) { return __uint_as_float(w << 16); }
__device__ __forceinline__ float bf_hi(unsigned w) { return __uint_as_float(w & 0xffff0000u); }
__device__ __forceinline__ float fast_sigmoid(float x) { return __builtin_amdgcn_rcpf(1.f + __builtin_amdgcn_exp2f(-1.4426950408889634f * x)); }
__device__ __forceinline__ void rope8(f32x4& v0, f32x4& v1, const float (&frq)[4], float pos) {
    float x[8] = {v0[0], v0[1], v0[2], v0[3], v1[0], v1[1], v1[2], v1[3]};
#pragma unroll
    for (int p = 0; p < 4; ++p) {
        float rev = pos * frq[p]; rev = __builtin_amdgcn_fractf(rev);
        const float s = __builtin_amdgcn_sinf(rev), c = __builtin_amdgcn_cosf(rev);
        const float a = x[2 * p], b = x[2 * p + 1];
        x[2 * p] = a * c - b * s; x[2 * p + 1] = b * c + a * s;
    }
    v0 = (f32x4){x[0], x[1], x[2], x[3]}; v1 = (f32x4){x[4], x[5], x[6], x[7]};
}
__device__ __forceinline__ float rope_freq(int idx, int half) {
    return __builtin_amdgcn_exp2f(-(float)idx / (float)half * 13.287712379549449f) * 0.15915494309189535f;
}
__device__ __forceinline__ u32x4 pack8(const f32x4& v0, const f32x4& v1) {
    u32x4 w; w.x = cvt_pk_bf16(v0[0], v0[1]); w.y = cvt_pk_bf16(v0[2], v0[3]); w.z = cvt_pk_bf16(v1[0], v1[1]); w.w = cvt_pk_bf16(v1[2], v1[3]); return w;
}

struct EpiProj {
    static constexpr bool PERM = true;
    bf16_t* proj; const float* b_gate; float* ssq; unsigned char* lat8;
    __device__ __forceinline__ void bias(const Unit& u, int wr, int wc, int fq, f32x4 (&b)[2][2]) const {
        const int cg = u.pn * BM + wc * 32 + 8 * fq - 4352;
#pragma unroll
        for (int bj = 0; bj < 2; ++bj)
#pragma unroll
            for (int n = 0; n < 2; ++n) b[bj][n] = u.pn >= 17 ? *(const f32x4*)(b_gate + cg + bj * HALF + 4 * n) : (f32x4){0.f, 0.f, 0.f, 0.f};
    }
    __device__ __forceinline__ void operator()(const f32x4 (&acc)[2][2][4][2], const Unit& u, int wr, int wc, int fr, int fq) const {
        const int pn = u.pn, row0 = u.row_off + wr * 64 + fr, colt = pn * BM + wc * 32 + 8 * fq;
        const bool t_rot = (pn >= 2 && pn <= 10) || pn == 15 || pn == 16, t_sig = pn >= 17, t_ssq = pn < 3;
        const float scl = (pn == 15 || pn == 16) ? 0.125f : 1.f;
        float frq[2][4];
#pragma unroll
        for (int bj = 0; bj < 2; ++bj) {
            const int cg = colt + bj * HALF; int H = 0, idx0 = 0;
            if (cg >= 640 && cg < 704) { H = 32; idx0 = (cg - 640) >> 1; }
            else if (cg >= 704 && cg < 768) { if (cg - 704 < 32) { H = 16; idx0 = (cg - 704) >> 1; } }
            else if (cg >= 768 && cg < 2816) { H = 64; idx0 = ((cg - 768) & 127) >> 1; }
            else if (cg >= 3840 && cg < 4352) { if (((cg - 3840) & 63) < 32) { H = 16; idx0 = ((cg - 3840) & 63) >> 1; } }
#pragma unroll
            for (int p = 0; p < 4; ++p) frq[bj][p] = H ? rope_freq(idx0 + p, H) : 0.f;
        }
#pragma unroll
        for (int ai = 0; ai < 2; ++ai)
#pragma unroll
            for (int m = 0; m < 4; ++m) {
                const int row = row0 + ai * HALF + m * 16; const float pos = (float)(row & 2047);
                bf16_t* rowp = proj + (size_t)row * 6400 + colt;
#pragma unroll
                for (int bj = 0; bj < 2; ++bj) {
                    f32x4 v0 = acc[ai][bj][m][0], v1 = acc[ai][bj][m][1];
                    if (t_ssq) {
                        float s = (v0[0] * v0[0] + v0[1] * v0[1]) + (v0[2] * v0[2] + v0[3] * v0[3]) + (v1[0] * v1[0] + v1[1] * v1[1]) + (v1[2] * v1[2] + v1[3] * v1[3]);
                        s += __shfl_xor(s, 16); s += __shfl_xor(s, 32);
                        if (fq == 0) ssq[(size_t)row * 24 + pn * 8 + bj * 4 + wc] = s;
                    }
                    if (t_rot) rope8(v0, v1, frq[bj], pos);
                    if (t_sig) {
#pragma unroll
                        for (int j = 0; j < 4; ++j) { v0[j] = fast_sigmoid(v0[j]); v1[j] = fast_sigmoid(v1[j]); } }
                    v0 = v0 * scl; v1 = v1 * scl;
                    *(u32x4*)(rowp + bj * HALF) = pack8(v0, v1);
                    if (pn < 2 || (pn == 2 && bj == 0)) { int w0 = 0, w1 = 0;
                        w0 = __builtin_amdgcn_cvt_pk_fp8_f32(v0[0] * 16.f, v0[1] * 16.f, w0, false); w0 = __builtin_amdgcn_cvt_pk_fp8_f32(v0[2] * 16.f, v0[3] * 16.f, w0, true);
                        w1 = __builtin_amdgcn_cvt_pk_fp8_f32(v1[0] * 16.f, v1[1] * 16.f, w1, false); w1 = __builtin_amdgcn_cvt_pk_fp8_f32(v1[2] * 16.f, v1[3] * 16.f, w1, true);
                        u32x2 w; w.x = (unsigned)w0; w.y = (unsigned)w1; *(u32x2*)(lat8 + (size_t)row * 640 + colt + bj * HALF) = w; }
                }
            }
    }
};

struct EpiMla {
    static constexpr bool PERM = true;
    bf16_t* out; int ldc; const float* ssq; int s0, ns; float invn; int rope;
    __device__ __forceinline__ void bias(const Unit&, int, int, int, f32x4 (&b)[2][2]) const { b[0][0] = b[0][1] = b[1][0] = b[1][1] = (f32x4){0.f, 0.f, 0.f, 0.f}; }
    __device__ __forceinline__ void operator()(const f32x4 (&acc)[2][2][4][2], const Unit& u, int wr, int wc, int fr, int fq) const {
        const int row0 = u.row_off + wr * 64 + fr, colt = u.pn * BM + wc * 32 + 8 * fq;
        float frq[2][4];
#pragma unroll
        for (int bj = 0; bj < 2; ++bj) { const int d = (colt + bj * HALF) % 192; const bool rt = rope && d >= 128;
#pragma unroll
            for (int p = 0; p < 4; ++p) frq[bj][p] = rt ? rope_freq(((d - 128) >> 1) + p, 32) : 0.f; }
#pragma unroll
        for (int ai = 0; ai < 2; ++ai) {
            f32x4 pa[4], pb[4], pc[4];
#pragma unroll
            for (int m = 0; m < 4; ++m) { const f32x4* sp = (const f32x4*)(ssq + (size_t)(row0 + ai * HALF + m * 16) * 24 + s0);
                pa[m] = sp[0]; pb[m] = sp[1]; pc[m] = (ns > 8) ? sp[2] : (f32x4){0.f, 0.f, 0.f, 0.f}; }
#pragma unroll
            for (int m = 0; m < 4; ++m) {
                const int row = row0 + ai * HALF + m * 16; const float pos = (float)(row & 2047);
                const f32x4 a = pa[m], b = pb[m], c = pc[m];
                const float tot = ((a[0] + a[1]) + (a[2] + a[3])) + ((b[0] + b[1]) + (b[2] + b[3])) + ((c[0] + c[1]) + (c[2] + c[3]));
                const float r = __builtin_amdgcn_rsqf(tot * invn + 1e-6f);
                bf16_t* rowp = out + (size_t)row * ldc + colt;
#pragma unroll
                for (int bj = 0; bj < 2; ++bj) {
                    f32x4 v0 = acc[ai][bj][m][0] * r, v1 = acc[ai][bj][m][1] * r;
                    if (rope) rope8(v0, v1, frq[bj], pos);
                    *(u32x4*)(rowp + bj * HALF) = pack8(v0, v1);
                }
            }
            asm volatile("" ::: "memory");
        }
    }
};

struct EpiGate {
    static constexpr bool PERM = true;
    bf16_t* out; const bf16_t* prev; const bf16_t* gate; unsigned char* out8;
    __device__ __forceinline__ void bias(const Unit&, int, int, int, f32x4 (&b)[2][2]) const { b[0][0] = b[0][1] = b[1][0] = b[1][1] = (f32x4){0.f, 0.f, 0.f, 0.f}; }
    __device__ __forceinline__ void operator()(const f32x4 (&acc)[2][2][4][2], const Unit& u, int wr, int wc, int fr, int fq) const {
        const int row0 = u.row_off + wr * 64 + fr, colt = u.pn * BM + wc * 32 + 8 * fq;
#pragma unroll
        for (int ai = 0; ai < 2; ++ai) {
            u32x4 gg[4][2], qq[4][2];
#pragma unroll
            for (int m = 0; m < 4; ++m)
#pragma unroll
                for (int bj = 0; bj < 2; ++bj) { const int row = row0 + ai * HALF + m * 16, col = colt + bj * HALF;
                    gg[m][bj] = *(const u32x4*)(gate + (size_t)row * 6400 + col);
                    qq[m][bj] = prev ? *(const u32x4*)(prev + (size_t)row * 1024 + col) : (u32x4){0u, 0u, 0u, 0u}; }
#pragma unroll
            for (int m = 0; m < 4; ++m)
#pragma unroll
                for (int bj = 0; bj < 2; ++bj) { const int row = row0 + ai * HALF + m * 16, col = colt + bj * HALF;
                    const u32x4 g = gg[m][bj], q = qq[m][bj];
                    f32x4 v0 = acc[ai][bj][m][0], v1 = acc[ai][bj][m][1];
                    v0[0] = fmaf(v0[0], bf_lo(g.x), bf_lo(q.x)); v0[1] = fmaf(v0[1], bf_hi(g.x), bf_hi(q.x)); v0[2] = fmaf(v0[2], bf_lo(g.y), bf_lo(q.y)); v0[3] = fmaf(v0[3], bf_hi(g.y), bf_hi(q.y));
                    v1[0] = fmaf(v1[0], bf_lo(g.z), bf_lo(q.z)); v1[1] = fmaf(v1[1], bf_hi(g.z), bf_hi(q.z)); v1[2] = fmaf(v1[2], bf_lo(g.w), bf_lo(q.w)); v1[3] = fmaf(v1[3], bf_hi(g.w), bf_hi(q.w));
                    if (out8) { int w0 = 0, w1 = 0;
#pragma unroll
                        for (int j = 0; j < 4; ++j) { v0[j] = __builtin_amdgcn_fmed3f(v0[j] * 64.f, -448.f, 448.f); v1[j] = __builtin_amdgcn_fmed3f(v1[j] * 64.f, -448.f, 448.f); }
                        w0 = __builtin_amdgcn_cvt_pk_fp8_f32(v0[0], v0[1], w0, false); w0 = __builtin_amdgcn_cvt_pk_fp8_f32(v0[2], v0[3], w0, true);
                        w1 = __builtin_amdgcn_cvt_pk_fp8_f32(v1[0], v1[1], w1, false); w1 = __builtin_amdgcn_cvt_pk_fp8_f32(v1[2], v1[3], w1, true);
                        u32x2 w; w.x = (unsigned)w0; w.y = (unsigned)w1; *(u32x2*)(out8 + (size_t)row * 1024 + col) = w; }
                    else *(u32x4*)(out + (size_t)row * 1024 + col) = pack8(v0, v1); }
            asm volatile("" ::: "memory");
        }
    }
};

struct EpiX1 {
    static constexpr bool PERM = false;
    const float* x; float* x1; float* ssq1;
    __device__ __forceinline__ void bias(const Unit&, int, int, int, f32x4 (&b)[2][2]) const { b[0][0] = b[0][1] = b[1][0] = b[1][1] = (f32x4){0.f, 0.f, 0.f, 0.f}; }
    __device__ __forceinline__ void operator()(const f32x4 (&acc)[2][2][4][2], const Unit& u, int wr, int wc, int fr, int fq) const {
        const int row0 = u.row_off + wr * 64 + fr, col0 = u.pn * BM + wc * 32 + 4 * fq;
#pragma unroll
        for (int ai = 0; ai < 2; ++ai) {
            f32x4 bs[4][2][2];
#pragma unroll
            for (int m = 0; m < 4; ++m) { const size_t off = (size_t)(row0 + ai * HALF + m * 16) * 1024 + col0;
#pragma unroll
                for (int bj = 0; bj < 2; ++bj)
#pragma unroll
                    for (int n = 0; n < 2; ++n) bs[m][bj][n] = *(const f32x4*)(x + off + bj * HALF + n * 16); }
#pragma unroll
            for (int m = 0; m < 4; ++m) { const int row = row0 + ai * HALF + m * 16; const size_t off = (size_t)row * 1024 + col0; float s = 0.f;
#pragma unroll
                for (int bj = 0; bj < 2; ++bj)
#pragma unroll
                    for (int n = 0; n < 2; ++n) { const f32x4 v = bs[m][bj][n] + acc[ai][bj][m][n]; *(f32x4*)(x1 + off + bj * HALF + n * 16) = v; s += (v[0] * v[0] + v[1] * v[1]) + (v[2] * v[2] + v[3] * v[3]); }
                s += __shfl_xor(s, 16); s += __shfl_xor(s, 32);
                if (fq == 0) ssq1[(size_t)row * 16 + u.pn * 4 + wc] = s; }
            asm volatile("" ::: "memory");
        }
    }
};

struct EpiAct {
    static constexpr bool PERM = true;
    bf16_t* act; const float* bgu;
    __device__ __forceinline__ void bias(const Unit& u, int wr, int wc, int fq, f32x4 (&b)[2][2]) const {
        const float* bg = bgu + (size_t)u.e * 2048 + u.pn * HALF + wc * 32 + 8 * fq;
#pragma unroll
        for (int n = 0; n < 2; ++n) { b[0][n] = *(const f32x4*)(bg + 4 * n); b[1][n] = *(const f32x4*)(bg + 1024 + 4 * n); }
    }
    __device__ __forceinline__ void operator()(const f32x4 (&acc)[2][2][4][2], const Unit& u, int wr, int wc, int fr, int fq) const {
        const int rr0 = wr * 64 + fr, cb = u.pn * HALF + wc * 32 + 8 * fq;
#pragma unroll
        for (int ai = 0; ai < 2; ++ai)
#pragma unroll
            for (int m = 0; m < 4; ++m) {
                const int rr = rr0 + ai * HALF + m * 16;
                f32x4 o[2];
#pragma unroll
                for (int n = 0; n < 2; ++n) { const f32x4 g = acc[ai][0][m][n], l = acc[ai][1][m][n]; f32x4 gt, ln, e;
#pragma unroll
                    for (int j = 0; j < 4; ++j) { gt[j] = __builtin_amdgcn_fmed3f(g[j], -3.0e38f, 7.0f); ln[j] = __builtin_amdgcn_fmed3f(l[j], -7.0f, 7.0f); }
                    e = gt * (-1.702f * 1.4426950408889634f);
#pragma unroll
                    for (int j = 0; j < 4; ++j) e[j] = __builtin_amdgcn_exp2f(e[j]);
                    e = e + 1.0f;
#pragma unroll
                    for (int j = 0; j < 4; ++j) e[j] = __builtin_amdgcn_rcpf(e[j]);
                    o[n] = (ln * 4.0f + 4.0f) * (gt * e); }
                if (rr < u.rows) { int w0 = 0, w1 = 0;
                    w0 = __builtin_amdgcn_cvt_pk_fp8_f32(o[0][0], o[0][1], w0, false); w0 = __builtin_amdgcn_cvt_pk_fp8_f32(o[0][2], o[0][3], w0, true);
                    w1 = __builtin_amdgcn_cvt_pk_fp8_f32(o[1][0], o[1][1], w1, false); w1 = __builtin_amdgcn_cvt_pk_fp8_f32(o[1][2], o[1][3], w1, true);
                    u32x2 w; w.x = (unsigned)w0; w.y = (unsigned)w1; *(u32x2*)((unsigned char*)act + (size_t)(u.row_off + rr) * 1024 + cb) = w; }
            }
    }
};

struct EpiY {
    static constexpr bool PERM = true;
    bf16_t* y; const float* bdn;
    __device__ __forceinline__ void bias(const Unit& u, int wr, int wc, int fq, f32x4 (&b)[2][2]) const {
        const float* bd = bdn + (size_t)u.e * 1024 + u.pn * BM + wc * 32 + 8 * fq;
#pragma unroll
        for (int bj = 0; bj < 2; ++bj)
#pragma unroll
            for (int n = 0; n < 2; ++n) b[bj][n] = *(const f32x4*)(bd + bj * HALF + 4 * n);
    }
    __device__ __forceinline__ void operator()(const f32x4 (&acc)[2][2][4][2], const Unit& u, int wr, int wc, int fr, int fq) const {
        const int rr0 = wr * 64 + fr, colt = u.pn * BM + wc * 32 + 16 * (fq >> 1), odd = fq & 1;
#pragma unroll
        for (int ai = 0; ai < 2; ++ai)
#pragma unroll
            for (int mp = 0; mp < 4; mp += 2) {
                const int rr = rr0 + ai * HALF + (mp + odd) * 16;
#pragma unroll
                for (int bj = 0; bj < 2; ++bj) { unsigned w[2][2];
#pragma unroll
                    for (int d = 0; d < 2; ++d) { const f32x4 v0 = acc[ai][bj][mp + d][0] * 16.f, v1 = acc[ai][bj][mp + d][1] * 16.f; int w0 = 0, w1 = 0;
                        w0 = __builtin_amdgcn_cvt_pk_fp8_f32(v0[0], v0[1], w0, false); w0 = __builtin_amdgcn_cvt_pk_fp8_f32(v0[2], v0[3], w0, true);
                        w1 = __builtin_amdgcn_cvt_pk_fp8_f32(v1[0], v1[1], w1, false); w1 = __builtin_amdgcn_cvt_pk_fp8_f32(v1[2], v1[3], w1, true);
                        w[d][0] = (unsigned)w0; w[d][1] = (unsigned)w1; }
                    const auto s0 = __builtin_amdgcn_permlane16_swap(w[0][0], w[1][0], false, false), s1 = __builtin_amdgcn_permlane16_swap(w[0][1], w[1][1], false, false);
                    if (rr < u.rows) { u32x4 o; o.x = s0[0]; o.y = s1[0]; o.z = s0[1]; o.w = s1[1]; *(u32x4*)((unsigned char*)y + (size_t)(u.row_off + rr) * 1024 + colt + bj * HALF) = o; }
                }
            }
    }
};
}
namespace att {
using bf16 = unsigned short;
using bf16x8 = __attribute__((ext_vector_type(8))) short;
using s16x4  = __attribute__((ext_vector_type(4))) short;
using f32x16 = __attribute__((ext_vector_type(16))) float;
using u32x4  = __attribute__((ext_vector_type(4))) unsigned;
constexpr int D = 128, NW = 8, QBLK = 32, KVBLK = 64;
constexpr float THR = 8.f;
constexpr size_t SHM_V = KVBLK * D * 2, SHM_K = KVBLK * D * 2, SHM_KR = KVBLK * 64 * 2;
constexpr size_t OFF_V = 0, OFF_K = 2 * SHM_V, OFF_KR = OFF_K + 2 * SHM_K, OFF_WS = OFF_KR + 2 * SHM_KR, OFF_QP = OFF_WS + NW * 64 * 4, SHM_ATTN = OFF_QP + NW * 4096;
#define KSWZ(row, colB) ((row) * 256 + ((colB) ^ (((row) & 15) << 4)))
#define KRSWZ(row, colB) ((row) * 128 + ((colB) ^ ((((row) >> 1) & 7) << 4)))
#define SBAR() __builtin_amdgcn_sched_barrier(0)
__device__ __forceinline__ int crow(int r, int hi) { return (r & 3) + 8 * (r >> 2) + 4 * hi; }
__device__ __forceinline__ unsigned cvtpk(float lo, float hi) { unsigned r; asm volatile("v_cvt_pk_bf16_f32 %0, %1, %2" : "=v"(r) : "v"(lo), "v"(hi)); return r; }

__device__ __forceinline__ void apply_mask(f32x16& p0, f32x16& p1, unsigned w) {
    const unsigned NEG = 0xff800000u;
#pragma unroll
    for (int r = 0; r < 16; ++r) {
        const unsigned t0 = (unsigned)__builtin_amdgcn_sbfe((int)w, r, 1), t1 = (unsigned)__builtin_amdgcn_sbfe((int)w, 16 + r, 1);
        p0[r] = __uint_as_float((__float_as_uint(p0[r]) & t0) | (NEG & ~t0));
        p1[r] = __uint_as_float((__float_as_uint(p1[r]) & t1) | (NEG & ~t1));
    }
}
template <int MODE>
__device__ __forceinline__ void partialSM(f32x16& p0, f32x16& p1, float& m_reg, float& mn, float& alpha) {
    constexpr float SCALE = MODE == 0 ? 0.07216878364870322f : 0.08838834764831845f;
    constexpr float C = SCALE * 1.4426950408889634f;
    float pmax = p0[0];
#pragma unroll
    for (int r = 1; r < 16; ++r) pmax = fmaxf(pmax, p0[r]);
#pragma unroll
    for (int r = 0; r < 16; ++r) pmax = fmaxf(pmax, p1[r]);
    { auto rr = __builtin_amdgcn_permlane32_swap(__float_as_uint(pmax), __float_as_uint(pmax), false, false);
      pmax = fmaxf(__uint_as_float(rr[0]), __uint_as_float(rr[1])); }
    if (__builtin_expect(__all(pmax - m_reg <= THR / SCALE), 1)) { mn = m_reg; alpha = 1.f; }
    else { mn = fmaxf(m_reg, pmax); alpha = __builtin_amdgcn_exp2f((m_reg - mn) * C); m_reg = mn; }
    const float mnC = -mn * C;
#pragma unroll
    for (int r = 0; r < 16; ++r) p0[r] = fmaf(p0[r], C, mnC);
#pragma unroll
    for (int r = 0; r < 16; ++r) p1[r] = fmaf(p1[r], C, mnC);
#pragma unroll
    for (int r = 0; r < 16; ++r) p0[r] = __builtin_amdgcn_exp2f(p0[r]);
}
__device__ __forceinline__ void finishSM(f32x16& p0, f32x16& p1, float alpha, float& l_reg, bf16x8& pa0, bf16x8& pa1, bf16x8& pa2, bf16x8& pa3) {
#pragma unroll
    for (int r = 0; r < 16; ++r) p1[r] = __builtin_amdgcn_exp2f(p1[r]);
    float ps = 0;
#pragma unroll
    for (int r = 0; r < 16; ++r) ps += p0[r];
#pragma unroll
    for (int r = 0; r < 16; ++r) ps += p1[r];
    { auto rr = __builtin_amdgcn_permlane32_swap(__float_as_uint(ps), __float_as_uint(ps), false, false);
      ps = __uint_as_float(rr[0]) + __uint_as_float(rr[1]); }
    l_reg = l_reg * alpha + ps;
#define PK4(P, BASE, OUT) do { unsigned a0 = cvtpk(P[BASE + 0], P[BASE + 1]), a1 = cvtpk(P[BASE + 2], P[BASE + 3]);   \
    unsigned b0 = cvtpk(P[BASE + 4], P[BASE + 5]), b1 = cvtpk(P[BASE + 6], P[BASE + 7]);                              \
    auto r0 = __builtin_amdgcn_permlane32_swap(a0, b0, false, false); auto r1 = __builtin_amdgcn_permlane32_swap(a1, b1, false, false); \
    u32x4 w = {r0[0], r1[0], r0[1], r1[1]}; OUT = *reinterpret_cast<bf16x8*>(&w); } while (0)
    PK4(p0, 0, pa0); PK4(p0, 8, pa1); PK4(p1, 0, pa2); PK4(p1, 8, pa3);
#undef PK4
}
template <int MODE>
__device__ __forceinline__ void qkt(f32x16& p0, f32x16& p1, const char* Ks, const char* Krs, const bf16x8* qr, const char* qpark, int r32, int hi) {
    constexpr int NREG = MODE == 0 ? 8 : 6;
    p0 = f32x16{}; p1 = f32x16{};
#pragma unroll
    for (int d0 = 0; d0 < 8; ++d0) { const int cb = (d0 * 16 + hi * 8) * 2;
        bf16x8 b0 = *reinterpret_cast<const bf16x8*>(Ks + KSWZ(r32, cb));
        bf16x8 b1 = *reinterpret_cast<const bf16x8*>(Ks + KSWZ(32 + r32, cb));
        const bf16x8 qv = d0 < NREG ? qr[d0 < NREG ? d0 : 0] : *reinterpret_cast<const bf16x8*>(qpark + (d0 - NREG) * 1024);
        p0 = __builtin_amdgcn_mfma_f32_32x32x16_bf16(b0, qv, p0, 0, 0, 0);
        p1 = __builtin_amdgcn_mfma_f32_32x32x16_bf16(b1, qv, p1, 0, 0, 0); }
    if constexpr (MODE == 0) {
#pragma unroll
        for (int d0 = 0; d0 < 4; ++d0) { const int cb = (d0 * 16 + hi * 8) * 2;
            bf16x8 b0 = *reinterpret_cast<const bf16x8*>(Krs + KRSWZ(r32, cb));
            bf16x8 b1 = *reinterpret_cast<const bf16x8*>(Krs + KRSWZ(32 + r32, cb));
            const bf16x8 qv = *reinterpret_cast<const bf16x8*>(qpark + d0 * 1024);
            p0 = __builtin_amdgcn_mfma_f32_32x32x16_bf16(b0, qv, p0, 0, 0, 0);
            p1 = __builtin_amdgcn_mfma_f32_32x32x16_bf16(b1, qv, p1, 0, 0, 0); }
    }
}
__device__ __forceinline__ int v_st(int k, int c) { const int kk = (k & ~0xC) | ((k & 4) << 1) | ((k & 8) >> 1); return ((kk >> 3) * 4 + (c >> 5)) * 512 + ((kk & 7) * 32 + (c & 31)) * 2; }
__device__ __forceinline__ int v_rd_base(int lane) { return ((lane & 3) << 3) | (((lane >> 2) & 3) << 6) | (((lane >> 4) & 1) << 5) | (((lane >> 5) & 1) << 8); }
constexpr int v_rd_off(int d0, int ks, int half) { return d0 * 512 + ks * 4096 + half * 2048; }
template <int OFF> __device__ __forceinline__ s16x4 tr_read(int vb) {
    s16x4 r; asm volatile("ds_read_b64_tr_b16 %0, %1 offset:%2" : "=&v"(r) : "v"(vb), "i"(OFF) : "memory"); return r;
}
template <int D0> __device__ __forceinline__ void pv_one(f32x16& od, int vb, bf16x8 pa0, bf16x8 pa1, bf16x8 pa2, bf16x8 pa3) {
    const s16x4 l0 = tr_read<v_rd_off(D0, 0, 0)>(vb), h0 = tr_read<v_rd_off(D0, 0, 1)>(vb), l1 = tr_read<v_rd_off(D0, 1, 0)>(vb), h1 = tr_read<v_rd_off(D0, 1, 1)>(vb);
    const s16x4 l2 = tr_read<v_rd_off(D0, 2, 0)>(vb), h2 = tr_read<v_rd_off(D0, 2, 1)>(vb), l3 = tr_read<v_rd_off(D0, 3, 0)>(vb), h3 = tr_read<v_rd_off(D0, 3, 1)>(vb);
    asm volatile("s_waitcnt lgkmcnt(0)" ::: "memory"); SBAR();
#define PK(L, H) (bf16x8){L[0], L[1], L[2], L[3], H[0], H[1], H[2], H[3]}
    od = __builtin_amdgcn_mfma_f32_32x32x16_bf16(pa0, PK(l0, h0), od, 0, 0, 0);
    od = __builtin_amdgcn_mfma_f32_32x32x16_bf16(pa1, PK(l1, h1), od, 0, 0, 0);
    od = __builtin_amdgcn_mfma_f32_32x32x16_bf16(pa2, PK(l2, h2), od, 0, 0, 0);
    od = __builtin_amdgcn_mfma_f32_32x32x16_bf16(pa3, PK(l3, h3), od, 0, 0, 0);
#undef PK
}
__device__ __forceinline__ void pv_d0(f32x16* o, int vb, bf16x8 pa0, bf16x8 pa1, bf16x8 pa2, bf16x8 pa3) {
    pv_one<0>(o[0], vb, pa0, pa1, pa2, pa3); pv_one<1>(o[1], vb, pa0, pa1, pa2, pa3); pv_one<2>(o[2], vb, pa0, pa1, pa2, pa3); pv_one<3>(o[3], vb, pa0, pa1, pa2, pa3);
}

template <int MODE, int LDQ, int LDK>
__device__ __forceinline__ void attn_unit(const bf16* __restrict__ Qb, const bf16* __restrict__ Kh, const bf16* __restrict__ Vh, const bf16* __restrict__ Krh,
                                          const unsigned* __restrict__ Mk, unsigned char* __restrict__ Ob, int i0, char* lds) {
    constexpr int NQ = MODE == 0 ? 12 : 8;
    int tid_ = threadIdx.x; asm volatile("" : "+v"(tid_));
    const int tid = tid_, wid = __builtin_amdgcn_readfirstlane(tid >> 6), lane = tid & 63, r32 = lane & 31, hi = lane >> 5;
    char* V_lds = lds + OFF_V; char* K_lds = lds + OFF_K; char* Kr_lds = lds + OFF_KR;
    float* ws = (float*)(lds + OFF_WS) + wid * 64; float* li_l = ws; float* al_l = ws + 32;
    constexpr int NREG = MODE == 0 ? 8 : 6;
    float m_reg = -1e30f, l_reg = 0; f32x16 o[4] = {}; bf16x8 qr[NREG];
    const bf16* Qw = Qb + (long)(wid * QBLK + r32) * LDQ + hi * 8;
    char* qpark = lds + OFF_QP + wid * 4096 + lane * 16;
#pragma unroll
    for (int d0 = 0; d0 < NREG; ++d0) qr[d0] = *reinterpret_cast<const bf16x8*>(Qw + d0 * 16);
#pragma unroll
    for (int d0 = NREG; d0 < NQ; ++d0) *reinterpret_cast<bf16x8*>(qpark + (d0 - NREG) * 1024) = *reinterpret_cast<const bf16x8*>(Qw + d0 * 16);
    const int sr = tid >> 4, sc = (tid & 15) * 8, vst0 = v_st(sr, sc), vst1 = v_st(32 + sr, sc);
    const int krr = tid >> 3, krc = (tid & 7) * 8;
    const int vb0 = (int)(uintptr_t)V_lds + v_rd_base(lane);
    const int NT = (i0 + 256) / KVBLK;
    const int jvis = (i0 >> 6) + (wid >> 1);
    const unsigned* Mw = Mk + ((size_t)(wid * QBLK + r32) * 32) * 2 + hi;
    struct { bf16x8 vs0, vs1, ks0, ks1, kr; } st;
#define SLOAD(k0) do { st.vs0 = *reinterpret_cast<const bf16x8*>(&Vh[(long)((k0) + sr) * LDK + sc]); st.vs1 = *reinterpret_cast<const bf16x8*>(&Vh[(long)((k0) + 32 + sr) * LDK + sc]); \
    st.ks0 = *reinterpret_cast<const bf16x8*>(&Kh[(long)((k0) + sr) * LDK + sc]); st.ks1 = *reinterpret_cast<const bf16x8*>(&Kh[(long)((k0) + 32 + sr) * LDK + sc]); \
    if constexpr (MODE == 0) st.kr = *reinterpret_cast<const bf16x8*>(&Krh[(long)((k0) + krr) * 6400 + krc]); } while (0)
#define SWRITE(b) do { *(bf16x8*)(V_lds + (b) * SHM_V + vst0) = st.vs0; *(bf16x8*)(V_lds + (b) * SHM_V + vst1) = st.vs1; const int kc = sc * 2; \
    *(bf16x8*)(K_lds + (b) * SHM_K + KSWZ(sr, kc)) = st.ks0; *(bf16x8*)(K_lds + (b) * SHM_K + KSWZ(32 + sr, kc)) = st.ks1; \
    if constexpr (MODE == 0) *(bf16x8*)(Kr_lds + (b) * SHM_KR + KRSWZ(krr, krc * 2)) = st.kr; } while (0)
#define RESC(a) do { if (__any((a) < 1.f)) { if (hi == 0) al_l[r32] = (a); asm volatile("s_waitcnt lgkmcnt(0)" ::: "memory"); \
    _Pragma("unroll") for (int d = 0; d < 4; ++d) _Pragma("unroll") for (int r = 0; r < 16; ++r) o[d][r] *= al_l[crow(r, hi)]; } } while (0)
#define MASKT(P0, P1, j, MWORD) do { if constexpr (MODE == 0) { if ((j) > jvis) { asm volatile("" ::: "memory");   \
        _Pragma("unroll") for (int r = 0; r < 16; ++r) { P0[r] = -INFINITY; P1[r] = -INFINITY; } } } \
    else { apply_mask(P0, P1, MWORD); } } while (0)
#define MLOAD(j) (MODE == 1 ? Mw[(j) * 2] : 0u)
    f32x16 pA0, pA1, pB0, pB1; float mnA, mnB, alA, alB; bf16x8 pa0, pa1, pa2, pa3;
    SLOAD(0); asm volatile("s_waitcnt vmcnt(0)" ::: "memory"); SWRITE(0); __syncthreads();
    unsigned mwA = MLOAD(0), mwB = MLOAD(1);
    qkt<MODE>(pA0, pA1, K_lds, Kr_lds, qr, qpark, r32, hi); MASKT(pA0, pA1, 0, mwA); partialSM<MODE>(pA0, pA1, m_reg, mnA, alA);
    SLOAD(KVBLK);
    SWRITE(1); __syncthreads();
    for (int j = 1; j + 1 < NT; j += 2) {
        SBAR(); qkt<MODE>(pB0, pB1, K_lds + SHM_K, Kr_lds + SHM_KR, qr, qpark, r32, hi);
        finishSM(pA0, pA1, alA, l_reg, pa0, pa1, pa2, pa3); SBAR();
        SLOAD((j + 1) * KVBLK); mwA = MLOAD(j + 1); SBAR();
        pv_d0(o, vb0, pa0, pa1, pa2, pa3); MASKT(pB0, pB1, j, mwB); partialSM<MODE>(pB0, pB1, m_reg, mnB, alB);
        __syncthreads(); SWRITE(0);
        RESC(alB); __syncthreads();
        SBAR(); qkt<MODE>(pA0, pA1, K_lds, Kr_lds, qr, qpark, r32, hi);
        finishSM(pB0, pB1, alB, l_reg, pa0, pa1, pa2, pa3); SBAR();
        SLOAD((j + 2) * KVBLK); mwB = MLOAD(j + 2); SBAR();
        pv_d0(o, vb0 + (int)SHM_V, pa0, pa1, pa2, pa3); MASKT(pA0, pA1, j + 1, mwA); partialSM<MODE>(pA0, pA1, m_reg, mnA, alA);
        __syncthreads(); SWRITE(1);
        RESC(alA); __syncthreads();
    }
    SBAR(); qkt<MODE>(pB0, pB1, K_lds + SHM_K, Kr_lds + SHM_KR, qr, qpark, r32, hi);
    finishSM(pA0, pA1, alA, l_reg, pa0, pa1, pa2, pa3); SBAR();
    pv_d0(o, vb0, pa0, pa1, pa2, pa3); MASKT(pB0, pB1, NT - 1, mwB); partialSM<MODE>(pB0, pB1, m_reg, mnB, alB);
    __syncthreads(); RESC(alB);
    finishSM(pB0, pB1, alB, l_reg, pa0, pa1, pa2, pa3); SBAR();
    pv_d0(o, vb0 + (int)SHM_V, pa0, pa1, pa2, pa3);
    if (hi == 0) li_l[r32] = l_reg; asm volatile("s_waitcnt lgkmcnt(0)" ::: "memory");
    unsigned char* Ow = Ob + (long)(wid * QBLK) * 2048;
    const int qi = lane & 3;
    const unsigned selA = (qi & 1) ? 0x03070105u : 0x06020400u, selB = (qi & 2) ? 0x03020706u : 0x05040100u;
#pragma unroll
    for (int rg = 0; rg < 4; ++rg) {
        float rinv[4];
#pragma unroll
        for (int k = 0; k < 4; ++k) rinv[k] = 32.f * __builtin_amdgcn_rcpf(li_l[crow(4 * rg + k, hi)]);
        unsigned char* orow = Ow + (long)(8 * rg + 4 * hi + qi) * 2048 + (r32 & ~3);
#pragma unroll
        for (int d0 = 0; d0 < 4; ++d0) {
            int w = 0;
            w = __builtin_amdgcn_cvt_pk_fp8_f32(o[d0][4 * rg] * rinv[0], o[d0][4 * rg + 1] * rinv[1], w, false);
            w = __builtin_amdgcn_cvt_pk_fp8_f32(o[d0][4 * rg + 2] * rinv[2], o[d0][4 * rg + 3] * rinv[3], w, true);
            const unsigned p1 = (unsigned)__builtin_amdgcn_update_dpp(0, w, 0xB1, 0xf, 0xf, true);
            const unsigned wa = __builtin_amdgcn_perm(p1, (unsigned)w, selA);
            const unsigned p2 = (unsigned)__builtin_amdgcn_update_dpp(0, (int)wa, 0x4E, 0xf, 0xf, true);
            *(unsigned*)(orow + d0 * 32) = __builtin_amdgcn_perm(p2, wa, selB);
        }
    }
    __syncthreads();
#undef SLOAD
#undef SWRITE
#undef RESC
#undef MASKT
#undef MLOAD
}
}
namespace idx {
using bf16 = unsigned short;
using bf16x8 = __attribute__((ext_vector_type(8))) short;
using f32x4 = __attribute__((ext_vector_type(4))) float;
using u32x4 = __attribute__((ext_vector_type(4))) unsigned;
using u32x2 = __attribute__((ext_vector_type(2))) unsigned;
constexpr int ROWW = 2052;
constexpr int LDS_BYTES = 16 * ROWW * 4;
#define IDX_LAS __attribute__((address_space(3)))

__device__ __forceinline__ float funkey(unsigned k) { return __uint_as_float((k & 0x80000000u) ? (k ^ 0x80000000u) : ~k); }
__device__ __forceinline__ unsigned fkey(float f) { const unsigned u = __float_as_uint(f + 0.0f); return u ^ ((unsigned)((int)u >> 31) | 0x80000000u); }
__device__ __forceinline__ void cnt_ge(unsigned& cnt, unsigned key, unsigned ref) { asm("v_cmp_ge_u32 vcc, %1, %2\n\tv_addc_co_u32 %0, vcc, 0, %0, vcc" : "+v"(cnt) : "v"(key), "v"(ref) : "vcc"); }
__device__ __forceinline__ void cnt_gt(unsigned& cnt, unsigned key, unsigned ref) { asm("v_cmp_gt_u32 vcc, %1, %2\n\tv_addc_co_u32 %0, vcc, 0, %0, vcc" : "+v"(cnt) : "v"(key), "v"(ref) : "vcc"); }
__device__ __forceinline__ void cnt_eq(unsigned& cnt, unsigned key, unsigned ref) { asm("v_cmp_eq_u32 vcc, %1, %2\n\tv_addc_co_u32 %0, vcc, 0, %0, vcc" : "+v"(cnt) : "v"(key), "v"(ref) : "vcc"); }
__device__ __forceinline__ void cnt_ge4(unsigned& c0, unsigned& c1, unsigned& c2, unsigned& c3, unsigned k0, unsigned k1, unsigned k2, unsigned k3, unsigned ref) {
    asm("v_cmp_ge_u32 s[70:71], %4, %8\n\tv_cmp_ge_u32 s[72:73], %5, %8\n\tv_cmp_ge_u32 s[74:75], %6, %8\n\tv_cmp_ge_u32 vcc, %7, %8\n\t"
        "v_addc_co_u32 %0, s[70:71], 0, %0, s[70:71]\n\tv_addc_co_u32 %1, s[72:73], 0, %1, s[72:73]\n\tv_addc_co_u32 %2, s[74:75], 0, %2, s[74:75]\n\tv_addc_co_u32 %3, vcc, 0, %3, vcc"
        : "+v"(c0), "+v"(c1), "+v"(c2), "+v"(c3) : "v"(k0), "v"(k1), "v"(k2), "v"(k3), "v"(ref) : "vcc", "s70", "s71", "s72", "s73", "s74", "s75");
}
#define IDX_DPP(v, ctrl) ((unsigned)__builtin_amdgcn_update_dpp(0, (int)(v), ctrl, 0xf, 0xf, true))
__device__ __forceinline__ unsigned half_sum(unsigned v) {
    v += IDX_DPP(v, 0xB1); v += IDX_DPP(v, 0x4E); v += IDX_DPP(v, 0x141); v += IDX_DPP(v, 0x140); { auto r = __builtin_amdgcn_permlane16_swap(v, v, false, false); v = r[0] + r[1]; } return v;
}
__device__ __forceinline__ unsigned half_min(unsigned v) {
    v = min(v, IDX_DPP(v, 0xB1)); v = min(v, IDX_DPP(v, 0x4E)); v = min(v, IDX_DPP(v, 0x141)); v = min(v, IDX_DPP(v, 0x140)); { auto r = __builtin_amdgcn_permlane16_swap(v, v, false, false); v = min(r[0], r[1]); } return v;
}
__device__ __forceinline__ unsigned half_max(unsigned v) {
    v = max(v, IDX_DPP(v, 0xB1)); v = max(v, IDX_DPP(v, 0x4E)); v = max(v, IDX_DPP(v, 0x141)); v = max(v, IDX_DPP(v, 0x140)); { auto r = __builtin_amdgcn_permlane16_swap(v, v, false, false); v = max(r[0], r[1]); } return v;
}

struct Conv { const float* wgu; const float* wdn; bf16* wgu_t; bf16* wdn_t; };
__device__ __forceinline__ unsigned f2bf_(float f) { const unsigned u = __float_as_uint(f); return (u + 0x7fffu + ((u >> 16) & 1u)) >> 16; }
struct ConvBuf { float v[8][8]; unsigned char* dst; };
__device__ __forceinline__ void conv_load(ConvBuf& B, const Conv& cv, int st, int lane) {
    const float* W; bf16* WT; int nsrc, srcc, nb, kb;
    if (st < 16384) { const int e = st >> 9, r = st & 511; kb = r >> 5; nb = r & 31; W = cv.wgu + (size_t)e * 1024 * 2048; WT = (bf16*)((unsigned char*)cv.wgu_t + (size_t)e * 2048 * 1024); nsrc = 2048;
        const int n = 64 * nb, pn = n >> 8, wth = n & 255; srcc = wth < 128 ? 128 * pn + wth : 1024 + 128 * pn + (wth - 128); }
    else { const int s2 = st - 16384, e = s2 >> 8, r = s2 & 255; kb = r >> 4; nb = r & 15; W = cv.wdn + (size_t)e * 1024 * 1024; WT = (bf16*)((unsigned char*)cv.wdn_t + (size_t)e * 1024 * 1024); nsrc = 1024; srcc = 64 * nb; }
    const float* src = W + (size_t)(64 * kb) * nsrc + srcc + lane;
    B.dst = (unsigned char*)WT + (size_t)(64 * nb + lane) * 1024 + 64 * kb;
#pragma unroll
    for (int s = 0; s < 8; ++s)
#pragma unroll
        for (int k = 0; k < 8; ++k) B.v[s][k] = src[(size_t)(8 * s + k) * nsrc];
}
__device__ __forceinline__ void conv_store(const ConvBuf& B) {
#pragma unroll
    for (int s = 0; s < 8; ++s) { int w0 = 0, w1 = 0;
        w0 = __builtin_amdgcn_cvt_pk_fp8_f32(B.v[s][0] * 64.f, B.v[s][1] * 64.f, w0, false); w0 = __builtin_amdgcn_cvt_pk_fp8_f32(B.v[s][2] * 64.f, B.v[s][3] * 64.f, w0, true);
        w1 = __builtin_amdgcn_cvt_pk_fp8_f32(B.v[s][4] * 64.f, B.v[s][5] * 64.f, w1, false); w1 = __builtin_amdgcn_cvt_pk_fp8_f32(B.v[s][6] * 64.f, B.v[s][7] * 64.f, w1, true);
        u32x2 o; o.x = (unsigned)w0; o.y = (unsigned)w1; *(u32x2*)(B.dst + 8 * s) = o; }
}
__device__ __forceinline__ void conv_super(const Conv& cv, int st, int lane) { ConvBuf B; conv_load(B, cv, st, lane); conv_store(B); }
struct ConvH { float v[4][8]; unsigned char* dst; };
__device__ __forceinline__ void conv_load_h(ConvH& B, const Conv& cv, int st, int hf, int lane) {
    const float* W; bf16* WT; int nsrc, srcc, nb, kb;
    if (st < 16384) { const int e = st >> 9, r = st & 511; kb = r >> 5; nb = r & 31; W = cv.wgu + (size_t)e * 1024 * 2048; WT = (bf16*)((unsigned char*)cv.wgu_t + (size_t)e * 2048 * 1024); nsrc = 2048;
        const int n = 64 * nb, pn = n >> 8, wth = n & 255; srcc = wth < 128 ? 128 * pn + wth : 1024 + 128 * pn + (wth - 128); }
    else { const int s2 = st - 16384, e = s2 >> 8, r = s2 & 255; kb = r >> 4; nb = r & 15; W = cv.wdn + (size_t)e * 1024 * 1024; WT = (bf16*)((unsigned char*)cv.wdn_t + (size_t)e * 1024 * 1024); nsrc = 1024; srcc = 64 * nb; }
    const float* src = W + (size_t)(64 * kb + 32 * hf) * nsrc + srcc + lane;
    B.dst = (unsigned char*)WT + (size_t)(64 * nb + lane) * 1024 + 64 * kb + 32 * hf;
#pragma unroll
    for (int s = 0; s < 4; ++s)
#pragma unroll
        for (int k = 0; k < 8; ++k) B.v[s][k] = src[(size_t)(8 * s + k) * nsrc];
}
__device__ __forceinline__ void conv_store_h(const ConvH& B) {
#pragma unroll
    for (int s = 0; s < 4; ++s) { int w0 = 0, w1 = 0;
        w0 = __builtin_amdgcn_cvt_pk_fp8_f32(B.v[s][0] * 64.f, B.v[s][1] * 64.f, w0, false); w0 = __builtin_amdgcn_cvt_pk_fp8_f32(B.v[s][2] * 64.f, B.v[s][3] * 64.f, w0, true);
        w1 = __builtin_amdgcn_cvt_pk_fp8_f32(B.v[s][4] * 64.f, B.v[s][5] * 64.f, w1, false); w1 = __builtin_amdgcn_cvt_pk_fp8_f32(B.v[s][6] * 64.f, B.v[s][7] * 64.f, w1, true);
        u32x2 o; o.x = (unsigned)w0; o.y = (unsigned)w1; *(u32x2*)(B.dst + 8 * s) = o; }
}
__device__ __forceinline__ void index_unit(const bf16* __restrict__ proj, const float* __restrict__ widx, unsigned* __restrict__ mask, int b, int qg, IDX_LAS unsigned char* lds,
                                           const Conv& cv, int tbase, int quota) {
    int tid_ = threadIdx.x; asm volatile("" : "+v"(tid_));
    const int tid = tid_, w = __builtin_amdgcn_readfirstlane(tid >> 6), lane = tid & 63;
    const int c = qg >> 2;
    ConvH H0, H1, H2;
#define CONV_ISSUE() do { if (quota) { conv_load_h(H0, cv, tbase + ((3 * w) >> 1), (3 * w) & 1, lane); conv_load_h(H1, cv, tbase + ((3 * w + 1) >> 1), (3 * w + 1) & 1, lane); \
                                        conv_load_h(H2, cv, tbase + ((3 * w + 2) >> 1), (3 * w + 2) & 1, lane); } } while (0)
#define CONV_RETIRE() do { if (quota) { conv_store_h(H0); conv_store_h(H1); conv_store_h(H2); } } while (0)
    IDX_LAS unsigned* kl = (IDX_LAS unsigned*)lds;
    const int j = lane & 31;
    if (c >= 4) {
        REPS(20) {
            const int q = lane & 15, g = lane >> 4;
            const size_t trow = (size_t)b * 2048 + 16 * qg + q;
            bf16x8 bq[8][2]; float wi[8];
            const bf16* qp = proj + trow * 6400 + 3840 + 8 * g;
#pragma unroll
            for (int h = 0; h < 8; ++h) { bq[h][0] = *reinterpret_cast<const bf16x8*>(qp + h * 64); bq[h][1] = *reinterpret_cast<const bf16x8*>(qp + h * 64 + 32); }
            { const f32x4 a0 = *(const f32x4*)(widx + trow * 8), a1 = *(const f32x4*)(widx + trow * 8 + 4);
              wi[0] = a0[0]; wi[1] = a0[1]; wi[2] = a0[2]; wi[3] = a0[3]; wi[4] = a1[0]; wi[5] = a1[1]; wi[6] = a1[2]; wi[7] = a1[3]; }
            bf16x8 ak[2][4][2];
            const bf16* kbase = proj + ((size_t)b * 2048 + q) * 6400 + 704 + 8 * g;
#define IDX_LOADK(buf, jj) do { _Pragma("unroll") for (int t = 0; t < 4; ++t) { const bf16* kp = kbase + (size_t)(64 * (jj) + 16 * t) * 6400; \
                ak[buf][t][0] = *reinterpret_cast<const bf16x8*>(kp); ak[buf][t][1] = *reinterpret_cast<const bf16x8*>(kp + 32); } } while (0)
            if (w <= c) IDX_LOADK(0, w);
#pragma unroll
            for (int s = 0; s < 4; ++s) {
                const int jt = w + 8 * s;
                __builtin_amdgcn_sched_barrier(0);
                if (s < 3) { if (jt + 8 <= c) IDX_LOADK((s + 1) & 1, jt + 8); }
                __builtin_amdgcn_sched_barrier(0);
                if (jt <= c) {
#pragma unroll
                    for (int t = 0; t < 4; ++t) {
                        f32x4 sc = {0.f, 0.f, 0.f, 0.f};
#pragma unroll
                        for (int h = 0; h < 8; ++h) {
                            f32x4 acc = {0.f, 0.f, 0.f, 0.f};
                            acc = __builtin_amdgcn_mfma_f32_16x16x32_bf16(ak[s & 1][t][0], bq[h][0], acc, 0, 0, 0);
                            acc = __builtin_amdgcn_mfma_f32_16x16x32_bf16(ak[s & 1][t][1], bq[h][1], acc, 0, 0, 0);
#pragma unroll
                            for (int r = 0; r < 4; ++r) sc[r] = fmaf(wi[h], __int_as_float(max(__float_as_int(acc[r]), 0)), sc[r]);
                        }
                        u32x4 kv; kv.x = fkey(sc[0]); kv.y = fkey(sc[1]); kv.z = fkey(sc[2]); kv.w = fkey(sc[3]);
                        *(IDX_LAS u32x4*)(kl + q * ROWW + 64 * jt + 4 * (4 * t + g)) = kv;
                    }
                }
            }
#undef IDX_LOADK
        }
        __syncthreads();
        CONV_ISSUE();
        {
            const int qq = 2 * w + (lane >> 5); unsigned w0, w1;
            const int nkeys = 64 * (c + 1), nch = (nkeys + 127) >> 7;
            unsigned key[16][4];
#pragma unroll
            for (int i = 0; i < 16; ++i) {
                u32x4 kv = {0u, 0u, 0u, 0u};
                if (i < nch) { if (128 * i + 4 * j < nkeys) kv = *(const IDX_LAS u32x4*)(kl + qq * ROWW + 128 * i + 4 * j); }
                key[i][0] = kv.x; key[i][1] = kv.y; key[i][2] = kv.z; key[i][3] = kv.w;
            }
            unsigned kmin = 0xffffffffu, kmax = 0u;
#pragma unroll
            for (int i = 0; i < 16; ++i)
                if (i < nch) {
                    const bool ok = 128 * i + 4 * j < nkeys;
#pragma unroll
                    for (int r = 0; r < 4; ++r) { kmin = min(kmin, ok ? key[i][r] : 0xffffffffu); kmax = max(kmax, key[i][r]); }
                }
            kmin = half_min(kmin); kmax = half_max(kmax);
            unsigned lo = kmin, hi = kmax + 1u;
            float flo = (float)(nkeys - 256), fhi = -256.f;
            int side = 0; bool done = false;
#pragma unroll 1
            for (int it = 0; ; ++it) {
                unsigned cand;
                if (hi - lo <= 1u) { done = true; cand = lo; }
                else if (it >= 24) cand = lo + ((hi - lo) >> 1);
                else {
                    const float vlo = funkey(lo), vhi = funkey(hi - 1u);
                    const float fr = (flo - fhi <= 6.f && (it & 1)) ? 0.5f : flo * __builtin_amdgcn_rcpf(flo - fhi);
                    cand = fkey(vlo + (vhi - vlo) * fr);
                    cand = cand <= lo ? lo + 1u : cand; cand = cand >= hi ? hi - 1u : cand;
                }
                if (__all(done)) break;
                unsigned c0 = 0, c1 = 0, c2 = 0, c3 = 0;
#pragma unroll
                for (int i = 0; i < 16; i += 4) if (i < nch) {
#pragma unroll
                    for (int d = 0; d < 4; ++d) cnt_ge4(c0, c1, c2, c3, key[i + d][0], key[i + d][1], key[i + d][2], key[i + d][3], cand); }
                const unsigned tot = half_sum((c0 + c1) + (c2 + c3));
                if (!done) {
                    const float f = (float)((int)tot - 256);
                    if (tot >= 256u) { lo = cand; flo = f; if (side == 1) fhi *= 0.5f; side = 1; }
                    else             { hi = cand; fhi = f; if (side == 2) flo *= 0.5f; side = 2; }
                    if (tot == 256u) done = true;
                }
            }
            const unsigned T = lo;
            unsigned gl = 0, el = 0;
#pragma unroll
            for (int i = 0; i < 16; ++i)
                if (i < nch) {
#pragma unroll
                    for (int r = 0; r < 4; ++r) { cnt_gt(gl, key[i][r], T); cnt_eq(el, key[i][r], T); }
                }
            const int need = 256 - (int)half_sum(gl), eqtot = (int)half_sum(el);
            const bool tie = __any(eqtot > need);
            IDX_LAS unsigned* mw = (IDX_LAS unsigned*)(lds + LDS_BYTES) + qq * 64;
            *(IDX_LAS u32x2*)(mw + 2 * j) = (u32x2){0u, 0u};
            const int hi_ = j & 1, sh_ = 16 * ((j >> 3) & 1) + 4 * ((j >> 1) & 3);
            int base = 0;
#pragma unroll
            for (int i = 0; i < 16; ++i)
                if (i < nch) {
                    unsigned nib = 0;
                    if (!tie) {
#pragma unroll
                        for (int r = 0; r < 4; ++r) nib |= (key[i][r] >= T) ? (1u << r) : 0u;
                    } else {
                        int e = 0;
#pragma unroll
                        for (int r = 0; r < 4; ++r) e += (key[i][r] == T) ? 1 : 0;
                        int incl = e;
#pragma unroll
                        for (int d = 1; d < 32; d <<= 1) { const int t = __shfl_up(incl, d, 32); if (j >= d) incl += t; }
                        int run = base + incl - e;
                        base += __shfl(incl, 31, 32);
#pragma unroll
                        for (int r = 0; r < 4; ++r) { const unsigned k = key[i][r]; const bool eq = (k == T); const bool sel = (k > T) || (eq && run < need); run += eq ? 1 : 0; nib |= sel ? (1u << r) : 0u; }
                    }
                    if (nib) (void)__hip_atomic_fetch_or(mw + (2 * i + (j >> 4)) * 2 + hi_, nib << sh_, __ATOMIC_RELAXED, __HIP_MEMORY_SCOPE_WORKGROUP);
                }
            asm volatile("s_waitcnt lgkmcnt(0)" ::: "memory");
            { const u32x2 o = *(const IDX_LAS u32x2*)(mw + 2 * j); w0 = o.x; w1 = o.y; }
            { u32x2 o; o.x = w0; o.y = w1; *(u32x2*)(mask + (((size_t)b * 2048 + 16 * qg + qq) * 32 + j) * 2) = o; }
        }
        CONV_RETIRE();
    } else {
        __syncthreads();
        CONV_ISSUE();
        {
            const int qq = 2 * w + (lane >> 5);
            u32x2 o; o.x = j <= c ? 0xffffffffu : 0u; o.y = o.x; *(u32x2*)(mask + (((size_t)b * 2048 + 16 * qg + qq) * 32 + j) * 2) = o;
        }
        CONV_RETIRE();
    }
    __syncthreads();
#undef CONV_ISSUE
#undef CONV_RETIRE
}
}
constexpr int NWAVES = 8;
constexpr int T = 32768, SEQ = 2048, NB = 16, DM = 1024, PP = 6400;
constexpr size_t MiB = 1u << 20;
constexpr size_t WS_CTL = 0, CTL_ZERO_BYTES = 64 * 1024;
constexpr size_t WS_WIDX = 1 * MiB;
constexpr size_t WS_SSQ  = 2 * MiB;
constexpr size_t WS_PICK = 5 * MiB;
constexpr size_t WS_WRH  = 5 * MiB + 512 * 1024;
constexpr size_t WS_MASK = 6 * MiB;
constexpr size_t WS_TOK  = 14 * MiB;
constexpr size_t WS_GATE = 18 * MiB;
constexpr size_t WS_WIN  = 22 * MiB;
constexpr size_t WS_WUQ  = WS_WIN + (size_t)6400 * 1024 * 2;
constexpr size_t WS_WUK  = WS_WUQ + (size_t)1536 * 384 * 2;
constexpr size_t WS_WUV  = WS_WUK + (size_t)1024 * 256 * 2;
constexpr size_t WS_WOA  = WS_WUV + (size_t)1024 * 256 * 2;
constexpr size_t WS_WOB  = WS_WOA + (size_t)1024 * 1024 * 2;
constexpr size_t WS_WOUT = WS_WOB + (size_t)1024 * 1024 * 2;
constexpr size_t WS_WGU  = 44 * MiB;
constexpr size_t WS_W8   = 108 * MiB;
constexpr size_t WS_WIN8 = WS_W8, WS_WOA8 = WS_W8 + 7 * MiB, WS_WOB8 = WS_W8 + 8 * MiB, WS_WOUT8 = WS_W8 + 9 * MiB, WS_WUQ8 = WS_W8 + 10 * MiB, WS_WUK8 = WS_W8 + 11 * MiB, WS_WUV8 = WS_WUK8 + 512 * 1024;
constexpr size_t WS_WDN  = 172 * MiB;
constexpr size_t WS_RA   = 236 * MiB;
constexpr size_t WS_RB   = 364 * MiB;
constexpr size_t WS_RC   = 764 * MiB;
constexpr size_t WS_END  = 1020 * MiB;
static_assert(WS_WOUT + (size_t)1024 * 1024 * 2 <= WS_WGU, "ws map");
constexpr size_t RC_Q = 0, RC_K = (size_t)T * 1536 * 2, RC_V = RC_K + (size_t)T * 1024 * 2;
constexpr size_t RC_MA = 0, RC_MG = (size_t)T * 1024 * 2;
constexpr int CW_BAR = 1024;
constexpr int CW_CNT = 8192;
constexpr int RING_BYTES = 131072, LDSCTL_OFF = 139264, MISC_OFF = LDSCTL_OFF + 320, TAB_OFF = LDSCTL_OFF + 1024  , LDS_BYTES = 147456;

#define GAS __attribute__((address_space(1)))
#define LAS __attribute__((address_space(3)))
typedef unsigned short bf16;
typedef unsigned v4u __attribute__((ext_vector_type(4)));
typedef unsigned v2u __attribute__((ext_vector_type(2)));
typedef float f32x4 __attribute__((ext_vector_type(4)));
#define LDS_WAIT() asm volatile("s_waitcnt lgkmcnt(0)" ::: "memory")
#define VM_WAIT() asm volatile("s_waitcnt vmcnt(0)" ::: "memory")
__device__ __forceinline__ unsigned f2bf(float f) { unsigned u = __builtin_bit_cast(unsigned, f); return (u + 0x7fffu + ((u >> 16) & 1u)) >> 16; }
__device__ __forceinline__ unsigned pk2(float lo, float hi) { return f2bf(lo) | (f2bf(hi) << 16); }

#define XB_TMO      128
#define XB_XCNT(j)  (256  + 64 * (j))
#define XB_XSUB(j)  (1280 + 64 * (j))
#define XB_XGEN(j)  (2304 + 64 * (j))
#define XB_TOP      3328
#define XB_TOPGEN   3392
#define XCD_BAR_WORDS 3456
#define XB_SPIN_CAP (1u << 25)
__device__ __forceinline__ unsigned xb_ld(unsigned* p)              { return __hip_atomic_load(p, __ATOMIC_RELAXED, __HIP_MEMORY_SCOPE_AGENT); }
__device__ __forceinline__ unsigned xb_add(unsigned* p, unsigned v) { return __hip_atomic_fetch_add(p, v, __ATOMIC_RELAXED, __HIP_MEMORY_SCOPE_AGENT); }
__device__ __forceinline__ unsigned xb_xcc_id() { return (unsigned)__builtin_amdgcn_s_getreg((3 << 11) | 20) & 0xFu; }
#define XB_SPIN(cond, bar) do { unsigned _sp = 0; while (cond) { __builtin_amdgcn_s_sleep(1); \
    if ((++_sp & 255u) == 0u) { if (xb_ld(&(bar)[XB_TMO])) break; if (_sp > XB_SPIN_CAP) { atomicAdd(&(bar)[XB_TMO], 1u); break; } } } } while (0)
struct XcdBarrier { unsigned* bar; unsigned x; volatile LAS unsigned* st; };
__device__ __forceinline__ XcdBarrier xcd_barrier_post(unsigned* bar, volatile LAS unsigned* st) {
    XcdBarrier b; b.bar = bar; b.x = xb_xcc_id(); b.st = st;
    if (threadIdx.x == 0) (void)xb_add(&bar[XB_XCNT(b.x)], 1u);
    return b;
}
__device__ __forceinline__ void xcd_barrier_complete(unsigned* bar, unsigned x, unsigned& nloc, unsigned& nx) {
    const unsigned G = gridDim.x * gridDim.y * gridDim.z;
    unsigned sum, cnt, mine, sp = 0u;
    for (;;) {
        sum = 0u; cnt = 0u; mine = 0u;
#pragma unroll
        for (unsigned j = 0; j < 16; ++j) { const unsigned c = xb_ld(&bar[XB_XCNT(j)]); sum += c; cnt += (c > 0u) ? 1u : 0u; mine = (j == x) ? c : mine; }
        if (sum == G) break;
        __builtin_amdgcn_s_sleep(1);
        if ((++sp & 255u) == 0u) { if (xb_ld(&bar[XB_TMO])) break; if (sp > XB_SPIN_CAP) { atomicAdd(&bar[XB_TMO], 1u); break; } }
    }
    nloc = mine > 0u ? mine : 1u; nx = cnt > 0u ? cnt : 1u;
}
__device__ __forceinline__ void xcd_barrier(const XcdBarrier& b) {
    asm volatile("s_waitcnt vmcnt(0)" ::: "memory");
    __syncthreads();
    if (threadIdx.x == 0) {
        unsigned* bar = b.bar;
        __builtin_amdgcn_s_waitcnt(0);
        unsigned nloc = b.st[0], nx = b.st[1];
        if (nloc == 0u) { xcd_barrier_complete(bar, b.x, nloc, nx); b.st[0] = nloc; b.st[1] = nx; }
        const unsigned old = xb_add(&bar[XB_XSUB(b.x)], 1u);
        const unsigned gen = old / nloc;
        if (old + 1u == (gen + 1u) * nloc) {
            __builtin_amdgcn_fence(__ATOMIC_RELEASE, "agent");
            asm volatile("s_waitcnt vmcnt(0)" ::: "memory");
            const unsigned og = xb_add(&bar[XB_TOP], 1u);
            const unsigned tg = og / nx;
            if (og + 1u == (tg + 1u) * nx) xb_add(&bar[XB_TOPGEN], 1u);
            else XB_SPIN(xb_ld(&bar[XB_TOPGEN]) == tg, bar);
            __builtin_amdgcn_fence(__ATOMIC_ACQUIRE, "agent");
            xb_add(&bar[XB_XGEN(b.x)], 1u);
            asm volatile("s_waitcnt vmcnt(0)" ::: "memory");
        } else {
            XB_SPIN(xb_ld(&bar[XB_XGEN(b.x)]) == gen, bar);
            __builtin_amdgcn_fence(__ATOMIC_ACQUIRE, "agent");
            asm volatile("s_waitcnt vmcnt(0)" ::: "memory");
        }
    }
    __syncthreads();
}

__device__ __forceinline__ float wave_sum(float v) {
#pragma unroll
    for (int o = 1; o < 64; o <<= 1) v += __shfl_xor(v, o);
    return v;
}

struct MapIn {
    static constexpr bool VEC2 = false;
    __device__ __forceinline__ static int src(int n) {
        if (n < 640) return n;
        if (n < 704) { const int j = n - 640; return 640 + ((j & 1) ? 32 + (j >> 1) : (j >> 1)); }
        if (n < 768) { const int j = n - 704; return 4288 + (j < 32 ? ((j & 1) ? 16 + (j >> 1) : (j >> 1)) : j); }
        if (n < 3840) { const int j = n - 768, part = j >> 10, hh = (j & 1023) >> 7, d = j & 127; const int base = 704 + part * 1024 + hh * 128;
            return base + (part < 2 ? ((d & 1) ? 64 + (d >> 1) : (d >> 1)) : d); }
        if (n < 4352) { const int j = n - 3840, hh = j >> 6, d = j & 63; return 3776 + hh * 64 + (d < 32 ? ((d & 1) ? 16 + (d >> 1) : (d >> 1)) : d); }
        return 4360 + (n - 4352);
    }
};
struct MapUq { static constexpr bool VEC2 = false; __device__ __forceinline__ static int src(int n) { const int hh = n / 192, d = n - hh * 192; if (d < 128) return n; const int j = d - 128; return hh * 192 + 128 + ((j & 1) ? 32 + (j >> 1) : (j >> 1)); } };
struct MapId { static constexpr bool VEC2 = true; __device__ __forceinline__ static int src(int n) { return n; } };
struct MapGu { static constexpr bool VEC2 = true; __device__ __forceinline__ static int src(int n) { const int pn = n >> 8, wth = n & 255; return wth < 128 ? 128 * pn + wth : 1024 + 128 * pn + (wth - 128); } };
template <class Map>
__device__ __forceinline__ void p0_transpose_item(const float* W, int K, int Nsrc, int nblk, bf16* WT, const float* kscale, LAS float* scr, int item, int lane, unsigned char* WT8 = nullptr, int K8 = 0) {
    const int kb = item / nblk, nb = item - kb * nblk, k0 = 64 * kb, n0 = 64 * nb;
    if constexpr (Map::VEC2) {
        const int sc = Map::src(n0 + 2 * (lane & 31)), hk = lane >> 5;
        typedef float f32x2_ __attribute__((ext_vector_type(2)));
        f32x2_ v[32];
#pragma unroll
        for (int i = 0; i < 32; ++i) v[i] = *(const GAS f32x2_*)(W + (size_t)(k0 + 2 * i + hk) * Nsrc + sc);
#pragma unroll
        for (int i = 0; i < 32; ++i) { const int kk = 2 * i + hk; float sc_ = kscale ? kscale[k0 + kk] : 1.f; scr[kk * 65 + 2 * (lane & 31)] = v[i].x * sc_; scr[kk * 65 + 2 * (lane & 31) + 1] = v[i].y * sc_; }
    } else {
    const int sc = Map::src(n0 + lane);
    float vv[64];
#pragma unroll
    for (int i = 0; i < 64; ++i) vv[i] = W[(size_t)(k0 + i) * Nsrc + sc];
#pragma unroll
    for (int i = 0; i < 64; ++i) { float v = vv[i]; if (kscale) v *= kscale[k0 + i]; scr[i * 65 + lane] = v; }
    }
    LDS_WAIT(); asm volatile("" ::: "memory");
    const int c = lane & 7;
#pragma unroll
    for (int j = 0; j < 8; ++j) { const int n = (lane >> 3) + 8 * j; const LAS float* s = scr + (8 * c) * 65 + n;
        if (WT) { v4u o; o.x = pk2(s[0 * 65], s[1 * 65]); o.y = pk2(s[2 * 65], s[3 * 65]); o.z = pk2(s[4 * 65], s[5 * 65]); o.w = pk2(s[6 * 65], s[7 * 65]);
            *(GAS v4u*)(WT + (size_t)(n0 + n) * K + k0 + 8 * c) = o; }
        if (WT8) { int w0 = 0, w1 = 0;
            w0 = __builtin_amdgcn_cvt_pk_fp8_f32(s[0 * 65] * 64.f, s[1 * 65] * 64.f, w0, false); w0 = __builtin_amdgcn_cvt_pk_fp8_f32(s[2 * 65] * 64.f, s[3 * 65] * 64.f, w0, true);
            w1 = __builtin_amdgcn_cvt_pk_fp8_f32(s[4 * 65] * 64.f, s[5 * 65] * 64.f, w1, false); w1 = __builtin_amdgcn_cvt_pk_fp8_f32(s[6 * 65] * 64.f, s[7 * 65] * 64.f, w1, true);
            v2u o8; o8.x = (unsigned)w0; o8.y = (unsigned)w1; *(GAS v2u*)(WT8 + (size_t)(n0 + n) * K8 + k0 + 8 * c) = o8; } }
    LDS_WAIT(); asm volatile("" ::: "memory");
}

#ifndef P1_BF16_TILES
#define P1_BF16_TILES ((1u << 2) | (1u << 15) | (1u << 16))
#endif
#ifndef PHASE_MASK
#define PHASE_MASK 0xFFFF
#endif
struct Args { const float* in[20]; float* out; unsigned char* ws; };

__global__ void __launch_bounds__(NWAVES * 64, 2) fwd_megakernel(Args args) {
    extern __shared__ __attribute__((aligned(16))) unsigned char lds[];
    LAS unsigned char* ldsl = (LAS unsigned char*)lds;
    volatile LAS unsigned* MISC = (volatile LAS unsigned*)(ldsl + MISC_OFF);
#define PHASE_IDS int tid_ = threadIdx.x; asm volatile("" : "+v"(tid_)); const int tid = tid_, lane = tid & 63, wave = __builtin_amdgcn_readfirstlane(tid >> 6); const int gw = vcu * NWAVES + wave, NGW = G * NWAVES; (void)lane; (void)gw; (void)NGW;
    const int G = gridDim.x, bx = blockIdx.x;
    const int vcu = (G % 8 == 0) ? (bx % 8) * (G / 8) + bx / 8 : bx;
    unsigned char* ws = args.ws;
    unsigned* ctl = (unsigned*)(ws + WS_CTL);
    const float* x = args.in[0]; const float* norm_attn_g = args.in[1]; const float* w_in = args.in[2]; const float* q_lora_g = args.in[3]; const float* kv_lora_g = args.in[4];
    const float* w_uq = args.in[5]; const float* w_uk = args.in[6]; const float* w_uv = args.in[7]; const float* w_o_mla = args.in[8]; const float* w_o_dsa = args.in[9];
    const float* b_gate = args.in[10]; const float* w_out = args.in[11]; const float* norm_ffn_g = args.in[12]; const float* w_router = args.in[13]; const float* b_router = args.in[14];
    const float* w_gate_up = args.in[15]; const float* b_gate_up = args.in[16]; const float* w_down = args.in[17]; const float* b_down = args.in[18]; const float* norm_final_g = args.in[19];
    float* out = args.out;
    float* widx = (float*)(ws + WS_WIDX); float* ssq = (float*)(ws + WS_SSQ); int* pick = (int*)(ws + WS_PICK); unsigned* mask = (unsigned*)(ws + WS_MASK);
    int* tokl = (int*)(ws + WS_TOK); float* gatek = (float*)(ws + WS_MASK);
    bf16* wrh = (bf16*)(ws + WS_WRH);
    bf16* win_t = (bf16*)(ws + WS_WIN); bf16* wuq_t = (bf16*)(ws + WS_WUQ); bf16* wuk_t = (bf16*)(ws + WS_WUK); bf16* wuv_t = (bf16*)(ws + WS_WUV);
    bf16* woa_t = (bf16*)(ws + WS_WOA); bf16* wob_t = (bf16*)(ws + WS_WOB); bf16* wout_t = (bf16*)(ws + WS_WOUT); bf16* wgu_t = (bf16*)(ws + WS_WGU); bf16* wdn_t = (bf16*)(ws + WS_WDN);
    bf16* hbuf = (bf16*)(ws + WS_RA); unsigned char* h8 = ws + WS_RA + 64 * MiB; unsigned char* win8 = ws + WS_WIN8;
    unsigned char* attn_out = ws + WS_RA; bf16* hn = (bf16*)(ws + WS_RA);
    unsigned char* woa8 = ws + WS_WOA8; unsigned char* wob8 = ws + WS_WOB8; unsigned char* wout8 = ws + WS_WOUT8; unsigned char* merged8 = ws + WS_RC + RC_MG;
    unsigned char* wuq8 = ws + WS_WUQ8; unsigned char* wuk8 = ws + WS_WUK8; unsigned char* wuv8 = ws + WS_WUV8; unsigned char* lat8 = ws + WS_RA + 96 * MiB;
    bf16* proj = (bf16*)(ws + WS_RB); bf16* act = (bf16*)(ws + WS_RB);
    bf16* mla_q = (bf16*)(ws + WS_RC + RC_Q); bf16* mla_k = (bf16*)(ws + WS_RC + RC_K); bf16* mla_v = (bf16*)(ws + WS_RC + RC_V);
    bf16* merged_a = (bf16*)(ws + WS_RC + RC_MA); bf16* merged = (bf16*)(ws + WS_RC + RC_MG); bf16* ybuf = (bf16*)(ws + WS_RC);
    unsigned* gcnt = ctl + CW_CNT;

    for (int u = threadIdx.x; u < (LDS_BYTES - LDSCTL_OFF) / 4; u += NWAVES * 64) ((LAS unsigned*)(ldsl + LDSCTL_OFF))[u] = 0u;
    __syncthreads();
    XcdBarrier bar = xcd_barrier_post(ctl + CW_BAR, MISC + 8);
#define GRID_BAR() xcd_barrier(bar)
    LAS int* cum = (LAS int*)(ldsl + TAB_OFF); LAS int* cntt = cum + 33; LAS int* offt = cntt + 32;

#if PHASE_MASK & (1 << 0)
    {
        PHASE_IDS
        LAS float* scr = (LAS float*)(ldsl + wave * 16640);
        constexpr int I_IN = 16 * 100, I_UQ = 6 * 24, I_UK = 4 * 16, I_UV = 4 * 16, I_O = 16 * 16, I_GU = 16 * 32, I_DN = 16 * 16;
        constexpr int NITEMS = I_IN + I_UQ + I_UK + I_UV + 3 * I_O;
        REPS(0) for (int it = gw; it < NITEMS; it += NGW) {
            int r = it;
            if (r < I_IN) { p0_transpose_item<MapIn>(w_in, 1024, 6408, 100, win_t, nullptr, scr, r, lane, win8, 1024); continue; } r -= I_IN;
            if (r < I_UQ) { p0_transpose_item<MapUq>(w_uq, 384, 1536, 24, nullptr, q_lora_g, scr, r, lane, wuq8, 512); continue; } r -= I_UQ;
            if (r < I_UK) { p0_transpose_item<MapId>(w_uk, 256, 1024, 16, nullptr, kv_lora_g, scr, r, lane, wuk8, 256); continue; } r -= I_UK;
            if (r < I_UV) { p0_transpose_item<MapId>(w_uv, 256, 1024, 16, nullptr, kv_lora_g, scr, r, lane, wuv8, 256); continue; } r -= I_UV;
            if (r < I_O) { p0_transpose_item<MapId>(w_o_mla, 1024, 1024, 16, nullptr, nullptr, scr, r, lane, woa8, 1024); continue; } r -= I_O;
            if (r < I_O) { p0_transpose_item<MapId>(w_o_dsa, 1024, 1024, 16, nullptr, nullptr, scr, r, lane, wob8, 1024); continue; } r -= I_O;
            p0_transpose_item<MapId>(w_out, 1024, 1024, 16, nullptr, nullptr, scr, r, lane, wout8, 1024);
        }
        __syncthreads();
        for (int idx = (int)blockIdx.x * (NWAVES * 64) + tid; idx < 1536 * 8; idx += G * NWAVES * 64) *(GAS v4u*)(wuq8 + (size_t)(idx >> 3) * 512 + 384 + 16 * (idx & 7)) = (v4u){0u, 0u, 0u, 0u};
        for (int idx = (int)blockIdx.x * (NWAVES * 64) + tid; idx < 32 * 1024; idx += G * NWAVES * 64) { const int e = idx >> 10, k = idx & 1023;
            const float xw = w_router[(size_t)k * 32 + e]; const unsigned hb = f2bf(xw); const float lw = xw - __uint_as_float(hb << 16);
            wrh[idx] = (bf16)hb; wrh[32 * 1024 + idx] = (bf16)f2bf(lw); }
        LAS float* wx = (LAS float*)ldsl;
        for (int i = tid; i < 8 * 1024; i += NWAVES * 64) { const int k = i >> 3, hh = i & 7; wx[hh * 1024 + k] = w_in[(size_t)k * 6408 + 4352 + hh]; }
        __syncthreads();
        REPS(10) for (int m = gw; m < T; m += NGW) {
            const GAS f32x4* xr = (const GAS f32x4*)(x + (size_t)m * DM) + lane;
            f32x4 v[4]; float s = 0.f;
#pragma unroll
            for (int j = 0; j < 4; ++j) { v[j] = xr[64 * j]; s += (v[j].x * v[j].x + v[j].y * v[j].y) + (v[j].z * v[j].z + v[j].w * v[j].w); }
            const float rstd = __builtin_amdgcn_rsqf(wave_sum(s) * (1.f / DM) + 1e-6f);
            GAS v2u* o8 = (GAS v2u*)(hbuf + (size_t)m * DM) + lane; GAS unsigned* o4 = (GAS unsigned*)(h8 + (size_t)m * DM) + lane;
#pragma unroll
            for (int j = 0; j < 4; ++j) { const f32x4 gg = *((const GAS f32x4*)norm_attn_g + lane + 64 * j); v[j] = v[j] * rstd * gg;
                v2u o; o.x = pk2(v[j].x, v[j].y); o.y = pk2(v[j].z, v[j].w); o8[64 * j] = o;
                int w8 = 0; w8 = __builtin_amdgcn_cvt_pk_fp8_f32(v[j].x * 16.f, v[j].y * 16.f, w8, false); w8 = __builtin_amdgcn_cvt_pk_fp8_f32(v[j].z * 16.f, v[j].w * 16.f, w8, true); o4[64 * j] = (unsigned)w8; }
            float mine = 0.f;
#pragma unroll
            for (int hh = 0; hh < 8; ++hh) { float d = 0.f;
#pragma unroll
                for (int j = 0; j < 4; ++j) { const f32x4 wv = *((const LAS f32x4*)(wx + hh * 1024) + lane + 64 * j); d += (v[j].x * wv.x + v[j].y * wv.y) + (v[j].z * wv.z + v[j].w * wv.w); }
                d = wave_sum(d); if (lane == hh) mine = d; }
            if (lane < 8) widx[(size_t)m * 8 + lane] = mine * 0.35355339059327373f;
        }
        __syncthreads();
    }
    GRID_BAR();

#endif
#if PHASE_MASK & (1 << 1)
#ifdef PROBE_XBAR
    for (int xb_ = 0; xb_ < PROBE_XBAR; ++xb_) GRID_BAR();
#endif
    REPS(1) {
        constexpr unsigned P1_BF16 = P1_BF16_TILES, P1_ALL = (1u << 25) - 1u;
        pg8::EpiProj E{proj, b_gate, ssq, lat8};
        if (P1_BF16) { pg8::DenseOrder S; S.init(hbuf, 1024, win_t, 1024, T, 6400, G, bx, 2, P1_BF16);
          pg8::gemm_phase<pg8::EpiProj, pg8::DenseOrder, false>(ldsl, 1024, 1024, S, E, rep_ > 0); }
        { pg8::DenseOrder S; S.init(h8, 1024, win8, 1024, T, 6400, G, bx, 1, P1_ALL & ~P1_BF16, true);
          pg8::gemm_phase<pg8::EpiProj, pg8::DenseOrder, true, true>(ldsl, 1024, 1024, S, E, rep_ > 0, 0x79797979, 0x7b7b7b7b); }
    }
    GRID_BAR();

#endif
#if PHASE_MASK & (1 << 2)
    {
        REPS(2) {
        { pg8::DenseOrder S; S.init(lat8, 640, wuq8, 512, T, 1536, G, bx, 1, 0u, true); pg8::EpiMla E{mla_q, 1536, ssq, 0, 12, 1.f / 384.f, 1};
          pg8::gemm_phase<pg8::EpiMla, pg8::DenseOrder, true, true>(ldsl, 512, 640, S, E, false, 0x79797979, 0x7b7b7b7b); }
        { pg8::DenseOrder S; S.init(lat8 + 384, 640, wuk8, 256, T, 1024, G, bx, 1, 0u, true); pg8::EpiMla E{mla_k, 1024, ssq, 12, 8, 1.f / 256.f, 0};
          pg8::gemm_phase<pg8::EpiMla, pg8::DenseOrder, true, true>(ldsl, 256, 640, S, E, false, 0x79797979, 0x7b7b7b7b); }
        { pg8::DenseOrder S; S.init(lat8 + 384, 640, wuv8, 256, T, 1024, G, bx, 1, 0u, true); pg8::EpiMla E{mla_v, 1024, ssq, 12, 8, 1.f / 256.f, 0};
          pg8::gemm_phase<pg8::EpiMla, pg8::DenseOrder, true, true>(ldsl, 256, 640, S, E, false, 0x79797979, 0x7b7b7b7b); }
        __syncthreads(); }
        REPS(12) {
            const idx::Conv cv{w_gate_up, w_down, wgu_t, wdn_t};
            int tdone = 0;
            for (int i = 0; ; ++i) { const int u = i * G + bx; if (u >= 2048) break;
                const int b = u >> 7, qraw = u & 127, qg = (i & 1) ? 127 - qraw : qraw;
                const int quota = (G == 256) ? min(12, 96 - tdone) : 0;
                idx::index_unit(proj, widx, mask, b, qg, ldsl, cv, vcu * 96 + tdone, quota); tdone += quota; }
            { const int w8 = __builtin_amdgcn_readfirstlane((int)threadIdx.x >> 6);
              if (G == 256) { for (int t = tdone + w8; t < 96; t += NWAVES) idx::conv_super(cv, vcu * 96 + t, (int)threadIdx.x & 63); }
              else { for (int st = vcu * NWAVES + w8; st < 24576; st += G * NWAVES) idx::conv_super(cv, st, (int)threadIdx.x & 63); } }
        }
    }
    GRID_BAR();

#endif
#if PHASE_MASK & (1 << 3)
    {
        for (int pass = 0; pass < 2; ++pass) REPS(3 + 10 * pass)
            for (int r = 0; ; ++r) {
                const int slot = r * G + ((r & 1) ? (G - 1 - bx) : bx); if (slot >= 1024) break;
                const int qb = 7 - (slot >> 7), bh = slot & 127, b = bh >> 3, h = bh & 7, i0 = qb * 256;
                const size_t row0 = (size_t)b * SEQ;
                if (pass == 0) REPS(33) {
#if !defined(ATT_ONLY) || ATT_ONLY == 0
                    att::attn_unit<0, 1536, 1024>(mla_q + (row0 + i0) * 1536 + h * 192, mla_k + row0 * 1024 + h * 128, mla_v + row0 * 1024 + h * 128, proj + row0 * PP + 640, nullptr,
                                                  attn_out + (row0 + i0) * 2048 + h * 128, i0, (char*)lds);
#endif
                } else REPS(34) {
#if !defined(ATT_ONLY) || ATT_ONLY == 1
                    att::attn_unit<1, PP, PP>(proj + (row0 + i0) * PP + 768 + h * 128, proj + row0 * PP + 1792 + h * 128, proj + row0 * PP + 2816 + h * 128, nullptr, mask + (row0 + i0) * 64,
                                              attn_out + (row0 + i0) * 2048 + 1024 + h * 128, i0, (char*)lds);
#endif
                }
            }
    }
    GRID_BAR();

#endif
#if PHASE_MASK & (1 << 4)
    REPS(4) {
        { pg8::DenseOrder S; S.init(attn_out, 2048, woa8, 1024, T, 1024, G, bx, 1, 0u, true); pg8::EpiGate E{merged_a, nullptr, proj + 4352, nullptr};
          pg8::gemm_phase<pg8::EpiGate, pg8::DenseOrder, true, true>(ldsl, 1024, 2048, S, E, false, 0x79797979, 0x7a7a7a7a); }
        VM_WAIT(); __syncthreads();
        { pg8::DenseOrder S; S.init(attn_out + 1024, 2048, wob8, 1024, T, 1024, G, bx, 1, 0u, true); pg8::EpiGate E{nullptr, merged_a, proj + 5376, merged8};
          pg8::gemm_phase<pg8::EpiGate, pg8::DenseOrder, true, true>(ldsl, 1024, 2048, S, E, false, 0x79797979, 0x7a7a7a7a); }
    }
    GRID_BAR();

#endif
#if PHASE_MASK & (1 << 5)
    REPS(5) {
        pg8::DenseOrder S; S.init(merged8, 1024, wout8, 1024, T, 1024, G, bx, 1, 0u, true); pg8::EpiX1 E{x, out, ssq};
        pg8::gemm_phase<pg8::EpiX1, pg8::DenseOrder, true, true>(ldsl, 1024, 1024, S, E, false, 0x79797979, 0x79797979);
    }
    GRID_BAR();

#endif
#if PHASE_MASK & (1 << 6)
    {
        PHASE_IDS
        LAS unsigned* cntl = (LAS unsigned*)(ldsl + 120 * 1024); LAS unsigned* basel = cntl + 32;
        LAS unsigned char* hnl = ldsl + wave * (2 * 16 * 272); LAS float* lgl = (LAS float*)(ldsl + 80 * 1024 + wave * (16 * 32 * 4));
        typedef short bf16x8_ __attribute__((ext_vector_type(8)));
        const int q = lane & 15, g = lane >> 4;
        REPS(6) for (int grp = bx; grp < T / 128; grp += G) {
            const bool fx_ = (REPEAT_PHASE != 6) || rep_ == 1;
            if (tid < 32) cntl[tid] = 0u;
            __syncthreads();
            const int t0 = grp * 128 + wave * 16;
            float myr = 0.f;
            if (lane < 16) { const GAS f32x4* sp = (const GAS f32x4*)(ssq + (size_t)(t0 + lane) * 16); const f32x4 a = sp[0], b = sp[1], c = sp[2], d = sp[3];
                const float tot = (((a[0] + a[1]) + (a[2] + a[3])) + ((b[0] + b[1]) + (b[2] + b[3]))) + (((c[0] + c[1]) + (c[2] + c[3])) + ((d[0] + d[1]) + (d[2] + d[3])));
                myr = __builtin_amdgcn_rsqf(tot * (1.f / DM) + 1e-6f); }
            f32x4 acc0, acc1;
            REPS(62) {
            acc0 = (f32x4){0.f, 0.f, 0.f, 0.f}; acc1 = (f32x4){0.f, 0.f, 0.f, 0.f};
            const bf16* wq = wrh + (size_t)q * 1024 + 8 * g;
            f32x4 xv[8];
#pragma unroll
            for (int ii = 0; ii < 8; ++ii) xv[ii] = *(const GAS f32x4*)(out + (size_t)(t0 + 2 * ii + (lane >> 5)) * DM + 4 * (lane & 31));
#pragma unroll 1
            for (int kc = 0; kc < 8; ++kc) {
                const int col = 128 * kc + 4 * (lane & 31);
                const f32x4 gg = *(const GAS f32x4*)(norm_ffn_g + col);
                bf16x8_ bh0[4], bl0[4], bh1[4], bl1[4];
#pragma unroll
                for (int s = 0; s < 4; ++s) { const bf16* p = wq + 128 * kc + 32 * s;
                    bh0[s] = *(const bf16x8_*)p; bh1[s] = *(const bf16x8_*)(p + 16 * 1024); bl0[s] = *(const bf16x8_*)(p + 32 * 1024); bl1[s] = *(const bf16x8_*)(p + 48 * 1024); }
#pragma unroll
                for (int ii = 0; ii < 8; ++ii) { const int i = 2 * ii + (lane >> 5); const float r = __shfl(myr, i);
                    f32x4 v = xv[ii] * r * gg;
                    const unsigned h0 = f2bf(v.x), h1 = f2bf(v.y), h2 = f2bf(v.z), h3 = f2bf(v.w);
                    v2u o; o.x = h0 | (h1 << 16); o.y = h2 | (h3 << 16);
                    { int w8 = 0; w8 = __builtin_amdgcn_cvt_pk_fp8_f32(v.x * 4.f, v.y * 4.f, w8, false); w8 = __builtin_amdgcn_cvt_pk_fp8_f32(v.z * 4.f, v.w * 4.f, w8, true);
                      *(GAS int*)((GAS unsigned char*)hn + (size_t)(t0 + i) * DM + col) = w8; }
                    v2u l; l.x = pk2(v.x - __uint_as_float(h0 << 16), v.y - __uint_as_float(h1 << 16)); l.y = pk2(v.z - __uint_as_float(h2 << 16), v.w - __uint_as_float(h3 << 16));
                    *(LAS v2u*)(hnl + i * 272 + 8 * (lane & 31)) = o; *(LAS v2u*)(hnl + 16 * 272 + i * 272 + 8 * (lane & 31)) = l; }
                if (kc < 7) {
#pragma unroll
                    for (int ii = 0; ii < 8; ++ii) xv[ii] = *(const GAS f32x4*)(out + (size_t)(t0 + 2 * ii + (lane >> 5)) * DM + col + 128);
                }
                LDS_WAIT(); asm volatile("" ::: "memory");
#pragma unroll
                for (int s = 0; s < 4; ++s) {
                    const bf16x8_ ah = *(const LAS bf16x8_*)(hnl + q * 272 + (32 * s + 8 * g) * 2), al = *(const LAS bf16x8_*)(hnl + 16 * 272 + q * 272 + (32 * s + 8 * g) * 2);
                    acc0 = __builtin_amdgcn_mfma_f32_16x16x32_bf16(ah, bh0[s], acc0, 0, 0, 0); acc1 = __builtin_amdgcn_mfma_f32_16x16x32_bf16(ah, bh1[s], acc1, 0, 0, 0);
                    acc0 = __builtin_amdgcn_mfma_f32_16x16x32_bf16(ah, bl0[s], acc0, 0, 0, 0); acc1 = __builtin_amdgcn_mfma_f32_16x16x32_bf16(ah, bl1[s], acc1, 0, 0, 0);
                    acc0 = __builtin_amdgcn_mfma_f32_16x16x32_bf16(al, bh0[s], acc0, 0, 0, 0); acc1 = __builtin_amdgcn_mfma_f32_16x16x32_bf16(al, bh1[s], acc1, 0, 0, 0);
                }
                LDS_WAIT(); asm volatile("" ::: "memory");
            }
            }
            { const float b0 = b_router[q], b1 = b_router[16 + q];
#pragma unroll
              for (int r = 0; r < 4; ++r) { lgl[(4 * g + r) * 32 + q] = acc0[r] + b0; lgl[(4 * g + r) * 32 + 16 + q] = acc1[r] + b1; } }
            LDS_WAIT(); asm volatile("" ::: "memory");
            int pe[4] = {0, 0, 0, 0}; float pg[4] = {0.f, 0.f, 0.f, 0.f}; unsigned prl[4] = {0u, 0u, 0u, 0u};
            if (lane < 16) {
                float lv[32];
#pragma unroll
                for (int e = 0; e < 32; ++e) lv[e] = lgl[lane * 32 + e];
                unsigned used = 0u; float tv[4];
#pragma unroll
                for (int k = 0; k < 4; ++k) { float best = -INFINITY; int bi = 0;
#pragma unroll
                    for (int e = 0; e < 32; ++e) { const bool ok = !((used >> e) & 1u) && lv[e] > best; best = ok ? lv[e] : best; bi = ok ? e : bi; }
                    used |= 1u << bi; pe[k] = bi; tv[k] = best; }
                const float e1 = __expf(tv[1] - tv[0]), e2 = __expf(tv[2] - tv[0]), e3 = __expf(tv[3] - tv[0]); const float inv = 1.f / (1.f + e1 + e2 + e3);
                pg[0] = inv; pg[1] = e1 * inv; pg[2] = e2 * inv; pg[3] = e3 * inv;
#pragma unroll
                for (int k = 0; k < 4; ++k) prl[k] = __hip_atomic_fetch_add(&cntl[pe[k]], 1u, __ATOMIC_RELAXED, __HIP_MEMORY_SCOPE_WORKGROUP);
            }
            __syncthreads();
            if (tid < 32 && fx_) basel[tid] = __hip_atomic_fetch_add(&gcnt[tid], cntl[tid], __ATOMIC_RELAXED, __HIP_MEMORY_SCOPE_AGENT);
            __syncthreads();
            if (lane < 16 && fx_) {
                const int tok = t0 + lane;
#pragma unroll
                for (int k = 0; k < 4; ++k) { const int e = pe[k]; const unsigned rank = basel[e] + prl[k];
                    tokl[(size_t)e * 32768 + rank] = tok; gatek[tok * 4 + k] = pg[k]; pick[tok * 4 + k] = (int)((rank << 5) | (unsigned)e); }
            }
            __syncthreads();
        }
    }
    GRID_BAR();

#endif
#if PHASE_MASK & (1 << 7)
    if (threadIdx.x == 0) { int c = 0, o = 0;
        for (int e = 0; e < 32; ++e) { const int n = (int)__hip_atomic_load(&gcnt[e], __ATOMIC_RELAXED, __HIP_MEMORY_SCOPE_AGENT); cum[e] = c; cntt[e] = n; offt[e] = o; c += (n + 255) >> 8; o += n; }
        cum[32] = c; offt[32] = o; }
    __syncthreads();
    REPS_RT(7) {
        pg8::MoeOrder S{cum, cntt, offt, 8, G, bx, 1024, (const char*)hn, (const char*)wgu_t, (size_t)2048 * 1024, tokl, true, 1};
        pg8::EpiAct E{act, b_gate_up};
        pg8::gemm_phase<pg8::EpiAct, pg8::MoeOrder, true, true>(ldsl, 1024, 1024, S, E, rep_ > 0);
    }
    GRID_BAR();
#endif
#if PHASE_MASK & (1 << 8)
    REPS_RT(8) {
        pg8::MoeOrder S{cum, cntt, offt, 4, G, bx, 1024, (const char*)act, (const char*)wdn_t, (size_t)1024 * 1024, nullptr, false, 1};
        pg8::EpiY E{ybuf, b_down};
        pg8::gemm_phase<pg8::EpiY, pg8::MoeOrder, true, true>(ldsl, 1024, 1024, S, E, rep_ > 0);
    }
    GRID_BAR();

#endif
#if PHASE_MASK & (1 << 9)
    {
        PHASE_IDS
        for (int m = gw; m < T; m += NGW) {
            GAS f32x4* xr = (GAS f32x4*)(out + (size_t)m * DM) + lane;
            f32x4 v[4];
#pragma unroll
            for (int j = 0; j < 4; ++j) v[j] = xr[64 * j];
#pragma unroll
            for (int k = 0; k < 4; ++k) { const int p = __builtin_amdgcn_readfirstlane(pick[m * 4 + k]); const int e = p & 31, rank = (int)((unsigned)p >> 5);
                const float gk = 0.0625f * __uint_as_float((unsigned)__builtin_amdgcn_readfirstlane((int)__float_as_uint(gatek[m * 4 + k])));
                const GAS unsigned* yr = (const GAS unsigned*)((const GAS unsigned char*)ybuf + (size_t)(offt[e] + rank) * DM) + lane;
#pragma unroll
                for (int j = 0; j < 4; ++j) { const int w = (int)yr[64 * j]; typedef float f32x2_ __attribute__((ext_vector_type(2))); const f32x2_ lo = __builtin_amdgcn_cvt_pk_f32_fp8(w, false), hi = __builtin_amdgcn_cvt_pk_f32_fp8(w, true);
                    v[j].x = fmaf(gk, lo.x, v[j].x); v[j].y = fmaf(gk, lo.y, v[j].y); v[j].z = fmaf(gk, hi.x, v[j].z); v[j].w = fmaf(gk, hi.y, v[j].w); } }
            float s = 0.f;
#pragma unroll
            for (int j = 0; j < 4; ++j) s += (v[j].x * v[j].x + v[j].y * v[j].y) + (v[j].z * v[j].z + v[j].w * v[j].w);
            const float rstd = __builtin_amdgcn_rsqf(wave_sum(s) * (1.f / DM) + 1e-6f);
#pragma unroll
            for (int j = 0; j < 4; ++j) { const f32x4 gg = *((const GAS f32x4*)norm_final_g + lane + 64 * j); xr[64 * j] = v[j] * rstd * gg; }
        }
    }
#endif
}

extern "C" void kernel_launch(void* const* d_in, const int* in_sizes, int n_in, void* d_out, int out_size, void* d_ws, size_t ws_size, hipStream_t stream) {
    static int grid = 0;
    if (grid == 0) {
        if (n_in != 20 || in_sizes[0] != T * DM || out_size != T * DM || ws_size < WS_END) { fprintf(stderr, "kernel_launch: unexpected shapes (n_in %d, in0 %d, out %d, ws %zu < %zu); nothing launched\n", n_in, n_in > 0 ? in_sizes[0] : -1, out_size, ws_size, (size_t)WS_END); grid = -1; return; }
        int dev = 0, cus = 0, per_cu = 0;
        if (hipGetDevice(&dev) != hipSuccess || hipDeviceGetAttribute(&cus, hipDeviceAttributeMultiprocessorCount, dev) != hipSuccess) { grid = -1; return; }
        if (hipFuncSetAttribute((const void*)fwd_megakernel, hipFuncAttributeMaxDynamicSharedMemorySize, LDS_BYTES) != hipSuccess) { fprintf(stderr, "kernel_launch: hipFuncSetAttribute failed\n"); grid = -1; return; }
        if (hipOccupancyMaxActiveBlocksPerMultiprocessor(&per_cu, (const void*)fwd_megakernel, NWAVES * 64, LDS_BYTES) != hipSuccess || per_cu < 1) { fprintf(stderr, "kernel_launch: occupancy query says %d\n", per_cu); }
        (void)hipGetLastError();
        grid = cus;
    }
    if (grid < 0) return;
    (void)hipMemsetAsync((char*)d_ws + WS_CTL, 0, CTL_ZERO_BYTES, stream);
    Args a{};
    for (int i = 0; i < 20; ++i) a.in[i] = (const float*)d_in[i];
    a.out = (float*)d_out; a.ws = (unsigned char*)d_ws;
    hipLaunchKernelGGL(fwd_megakernel, dim3(grid), dim3(NWAVES * 64), LDS_BYTES, stream, a);
}
```

```cpp
#include <hip/hip_runtime.h>
#include <cstdio>
#include <cstdint>
#include <cmath>
#ifndef REPEAT_PHASE
#define REPEAT_PHASE -1
#endif
#define REPS(k) for (int rep_ = 0; rep_ < ((REPEAT_PHASE == (k)) ? 2 : 1); ++rep_)
__device__ __forceinline__ int opaque_n(int n) { asm volatile("" : "+s"(n)); return n; }
#define REPS_RT(k) for (int rep_ = 0, nrep_ = (REPEAT_PHASE == (k)) ? opaque_n(2) : 1; rep_ < nrep_; ++rep_)
namespace pg8 {
#define PG8_LAS __attribute__((address_space(3)))
typedef unsigned short bf16_t;
typedef short bf16x8 __attribute__((ext_vector_type(8)));
typedef float f32x4 __attribute__((ext_vector_type(4)));
typedef float f32x2 __attribute__((ext_vector_type(2)));
typedef unsigned u32x4 __attribute__((ext_vector_type(4)));
typedef unsigned u32x2 __attribute__((ext_vector_type(2)));
constexpr int PG8_TOKL_OFF = 139264 + 2048;
constexpr int BM = 256, BK = 64, HALF = 128, HTB = HALF * BK * 2  , STAGE_BYTES = 8 * HTB, NXCD = 8, WGM = 8;

__host__ __device__ __forceinline__ int lds_byte(int r, int c) { const int st = (r >> 4) * 2 + (c >> 5), rr = r & 15, cc = c & 31, ob = rr * 64 + cc * 2; return st * 1024 + (ob ^ (((ob >> 9) & 1) << 5)); }
__host__ __device__ __forceinline__ void stage_rc(int b, int& R, int& C) { const int st = b / 1024, sb = b % 1024, swz = sb ^ (((sb >> 9) & 1) << 5); R = (st >> 1) * 16 + swz / 64; C = (st & 1) * 32 + (swz % 64) / 2; }
__host__ __device__ __forceinline__ int perm32(int rho) { const int n = rho >> 4, i = rho & 15; return 8 * (i >> 2) + 4 * n + (i & 3); }

struct Unit { int pm, pn, e, rows, row_off; const char* A; const char* B; const int* toks; };

struct TileOrder {
    int nM, nN, nwg, G, c;
    __device__ void init(int nM_, int nN_, int G_, int c_) { nM = nM_; nN = nN_; nwg = nM * nN; G = G_; c = c_; }
    __device__ bool tile(int i, int& pm, int& pn) const {
        const long L = (long)i * G + c; if (L >= nwg) return false;
        int wgid = (int)L; { const int q = nwg / NXCD, r = nwg % NXCD, xcd = wgid % NXCD, off = wgid / NXCD; wgid = (xcd < r ? xcd * (q + 1) : r * (q + 1) + (xcd - r) * q) + off; }
        const int nig = WGM * nN, gid = wgid / nig, fm = gid * WGM, gsz = (nM - fm) < WGM ? (nM - fm) : WGM;
        pm = fm + ((wgid % nig) % gsz); pn = (wgid % nig) / gsz; return true;
    }
};
struct DenseOrder {
    TileOrder t; const char* A; const char* B; int lda, K, esz; unsigned sel; bool lin;
    __device__ void init(const void* A_, int lda_, const void* B_, int K_, int M, int N, int G, int c, int esz_ = 2, unsigned sel_ = 0u, bool lin_ = false) { lin = lin_;
        t.init(M / BM, sel_ ? __builtin_popcount(sel_) : N / BM, G, c); A = (const char*)A_; B = (const char*)B_; lda = lda_; K = K_; esz = esz_; sel = sel_; }
    __device__ bool next(int i, Unit& u) const {
        int pm, pn; if (!t.tile(i, pm, pn)) return false;
        if (sel) { int left = pn, p = 0;
#pragma unroll 1
            for (int k = 0; k < 32; ++k) { if ((sel >> k) & 1u) { if (left == 0) p = k; --left; } }
            pn = p; }
        u.pm = pm; u.pn = pn; u.e = 0; u.rows = BM; u.row_off = pm * BM; u.A = lin ? A : A + (size_t)pm * BM * lda * esz; u.B = B + (size_t)pn * BM * K * esz; u.toks = nullptr; return true;
    }
};
struct MoeOrder {
    const PG8_LAS int* cum; const PG8_LAS int* cnt; const PG8_LAS int* off; int nN, G, c, K; const char* A; const char* B; size_t bstride; const int* toks; bool gather; int esz;
    __device__ bool next(int i, Unit& u) const {
        const int L0 = i * G + c; const int total = cum[32] * nN; if (L0 >= total) return false;
        int L = L0;
        if ((G & 7) == 0) { const int q = total >> 3, r = total & 7, xcd = L0 & 7, o = L0 >> 3; L = (xcd < r ? xcd * (q + 1) : r * (q + 1) + (xcd - r) * q) + o; }
        const int lk = (int)(threadIdx.x & 31u);
        const int e = __builtin_amdgcn_readfirstlane(__popcll(__ballot(L >= cum[lk + 1] * nN) & 0xffffffffull));
        const int te = cum[e + 1] - cum[e], r = L - cum[e] * nN, MB = 32 / nN;
        const int blk = r / (MB * nN), rr = r - blk * (MB * nN), rows = min(MB, te - blk * MB), pn = rr / rows, mt = blk * MB + (rr - pn * rows);
        u.pm = mt; u.pn = pn; u.e = e; u.rows = min(BM, cnt[e] - mt * BM); u.row_off = off[e] + mt * BM;
        u.B = B + (size_t)e * bstride + (size_t)pn * BM * K * esz;
        if (gather) { u.A = A; u.toks = toks + (size_t)e * 32768 + mt * BM; } else { u.A = A; u.toks = nullptr; }
        return true;
    }
};

__device__ __forceinline__ unsigned cvt_pk_bf16(float lo, float hi) { unsigned r; asm volatile("v_cvt_pk_bf16_f32 %0, %1, %2" : "=v"(r) : "v"(lo), "v"(hi)); return r; }

typedef int v8i32 __attribute__((ext_vector_type(8)));
typedef int v4i32 __attribute__((ext_vector_type(4)));
template <class Epi, class Sched, bool GATHER, bool F8 = false>
__device__ __forceinline__ void gemm_phase(PG8_LAS unsigned char* lds, const int K, const int lda, const Sched& S, const Epi& E, const bool noepi = false, const int SCL_B = 0x79797979  , const int SCL_A = 0x7d7d7d7d  ) {
    int tid_ = threadIdx.x; asm volatile("" : "+v"(tid_));
    const int tid = tid_, wid = __builtin_amdgcn_readfirstlane(tid >> 6), lane = tid & 63, wr = wid >> 2, wc = wid & 3, fr = lane & 15, fq = lane >> 4;
    constexpr int ESZ = F8 ? 1 : 2;
    int nt_ = (K * ESZ) / 128; asm volatile("" : "+s"(nt_)); const int nt = nt_;
    unsigned voffA[2], voffB[2];
#pragma unroll
    for (int i = 0; i < 2; ++i) { int R, C; stage_rc(tid * 16 + i * 8192, R, C); const int Rb = Epi::PERM ? ((R & ~31) + perm32(R & 31)) : R;
        voffA[i] = (unsigned)(R * lda * ESZ + C * 2); voffB[i] = (unsigned)(Rb * K * ESZ + C * 2); }
    const size_t kstep = (size_t)(BK * 2);
    const size_t hstepA = GATHER ? 0 : (size_t)HALF * lda * ESZ, hstepB = (size_t)HALF * K * ESZ;
    const unsigned ldsw = (unsigned)wid * 1024u;
    const int aoff = lds_byte(wr * 64 + fr, F8 ? fq * 16 : fq * 8), boff = lds_byte(wc * 32 + fr, F8 ? fq * 16 : fq * 8);
    constexpr int aoff1 = F8 ? 16 : 1024, boff1 = F8 ? 16 : 1024;
    unsigned vgC[2][2];
    const PG8_LAS int* tokl = (const PG8_LAS int*)(lds + PG8_TOKL_OFF);
#define PG8_SA(b, h) (((b) * 2 + (h)) * HTB)
#define PG8_SB(b, h) ((4 + (b) * 2 + (h)) * HTB)
#define PG8_STAGE(bufoff, gbase, voff) do { _Pragma("unroll") for (int _i = 0; _i < 2; ++_i) \
        __builtin_amdgcn_global_load_lds((const unsigned*)((const char*)(gbase) + (voff)[_i]), (PG8_LAS unsigned*)(lds + (bufoff) + ldsw + _i * 8192), 16, 0, 0); } while (0)
#define PG8_STAGEA(bufoff, gbase, h) do { if constexpr (GATHER) { PG8_STAGE(bufoff, gbase, vgC[h]); } else { PG8_STAGE(bufoff, (gbase) + (h) * hstepA, voffA); } } while (0)
#define PG8_GOFF(dst, u) do { _Pragma("unroll") for (int _h = 0; _h < 2; ++_h) _Pragma("unroll") for (int _i = 0; _i < 2; ++_i) { int _R, _C; stage_rc(tid * 16 + _i * 8192, _R, _C); const int _r = _h * HALF + _R; \
        const int _t = (u).toks ? (u).toks[min(_r, (u).rows - 1)] : (u).row_off + _r; dst[_h][_i] = (unsigned)(_t * lda * ESZ + _C * 2); } } while (0)
#define PG8_LD8(base) (__builtin_shufflevector(*(const PG8_LAS v4i32*)(base), *(const PG8_LAS v4i32*)((base) + aoff1_or_boff1), 0, 1, 2, 3, 4, 5, 6, 7))
#define PG8_LDA(dst, b, h) do { if constexpr (F8) { _Pragma("unroll") for (int m = 0; m < 4; ++m) { const int aoff1_or_boff1 = aoff1; dst##8[m] = PG8_LD8(lds + PG8_SA(b, h) + aoff + m * 2048); } } \
        else { _Pragma("unroll") for (int m = 0; m < 4; ++m) _Pragma("unroll") for (int k = 0; k < 2; ++k) dst[m][k] = *(const PG8_LAS bf16x8*)(lds + PG8_SA(b, h) + aoff + m * 2048 + k * 1024); } } while (0)
#define PG8_LDB(dst, b, h) do { if constexpr (F8) { _Pragma("unroll") for (int n = 0; n < 2; ++n) { const int aoff1_or_boff1 = boff1; dst##8[n] = PG8_LD8(lds + PG8_SB(b, h) + boff + n * 2048); } } \
        else { _Pragma("unroll") for (int n = 0; n < 2; ++n) _Pragma("unroll") for (int k = 0; k < 2; ++k) dst[n][k] = *(const PG8_LAS bf16x8*)(lds + PG8_SB(b, h) + boff + n * 2048 + k * 1024); } } while (0)
#define PG8_MMA(ai, bj, At, Bt) do { __builtin_amdgcn_s_setprio(1); _Pragma("unroll") for (int m = 0; m < 4; ++m) _Pragma("unroll") for (int n = 0; n < 2; ++n) { if constexpr (F8) { \
        acc[ai][bj][m][n] = __builtin_amdgcn_mfma_scale_f32_16x16x128_f8f6f4(Bt##8[n], At##8[m], acc[ai][bj][m][n], 0, 0, 0, SCL_B, 0, SCL_A); } else { _Pragma("unroll") for (int k = 0; k < 2; ++k) \
        acc[ai][bj][m][n] = __builtin_amdgcn_mfma_f32_16x16x32_bf16(Bt[n][k], At[m][k], acc[ai][bj][m][n], 0, 0, 0); } } __builtin_amdgcn_s_setprio(0); } while (0)
#define PG8_WAIT_V(n) asm volatile("s_waitcnt vmcnt(" #n ")" ::: "memory")
#define PG8_WAIT_L(n) asm volatile("s_waitcnt lgkmcnt(" #n ")" ::: "memory")
#define PG8_BAR __builtin_amdgcn_s_barrier()
#define PG8_SCHED __builtin_amdgcn_sched_barrier(0)
    Unit cur, nxt; int ui = 0;
    if (!S.next(0, cur)) return;
#ifdef STAGGER
    { const int dl = ((int)blockIdx.x >> 3) & 3; for (int k = 0; k < dl * STAGGER; ++k) __builtin_amdgcn_s_sleep(127); }
#endif
    f32x4 acc[2][2][4][2]; f32x4 binit[2][2];
    E.bias(cur, wr, wc, fq, binit);
#pragma unroll
    for (int a = 0; a < 2; ++a)
#pragma unroll
        for (int b = 0; b < 2; ++b)
#pragma unroll
            for (int m = 0; m < 4; ++m)
#pragma unroll
                for (int n = 0; n < 2; ++n) acc[a][b][m][n] = binit[b][n];
    bf16x8 At[4][2], B0[2][2], B1[2][2]; v8i32 At8[4], B08[2], B18[2];
    const char* cA = cur.A; const char* cB = cur.B;
    if constexpr (GATHER) { PG8_GOFF(vgC, cur); }
    PG8_STAGE(PG8_SB(0, 0), cB, voffB); PG8_STAGE(PG8_SB(0, 1), cB + hstepB, voffB); PG8_STAGEA(PG8_SA(0, 0), cA, 0); PG8_STAGEA(PG8_SA(0, 1), cA, 1);
    if (wr == 1) PG8_BAR;
    PG8_WAIT_V(2); PG8_BAR;
    PG8_STAGE(PG8_SB(1, 0), cB + kstep, voffB); PG8_STAGEA(PG8_SA(1, 0), cA + kstep, 0); PG8_STAGE(PG8_SB(1, 1), cB + hstepB + kstep, voffB);
    PG8_WAIT_V(6); PG8_BAR;
    for (;;) {
        const bool has_next = S.next(ui + 1, nxt);
        if constexpr (GATHER) { if (has_next && nxt.toks && tid < BM)
            __builtin_amdgcn_global_load_lds((const unsigned*)(nxt.toks + min(tid, nxt.rows - 1)), (PG8_LAS unsigned*)(lds + PG8_TOKL_OFF + (unsigned)wid * 256u), 4, 0, 0); }
        const char* nA = has_next ? nxt.A : cA; const char* nB = has_next ? nxt.B : cB;
#pragma unroll 1
        for (int t = 0; t < nt; t += 2) {
            const bool last = (t == nt - 2);
            const char* a1 = cA + (size_t)(t + 1) * kstep;
            const char* a2 = last ? nA : cA + (size_t)(t + 2) * kstep; const char* b2 = last ? nB : cB + (size_t)(t + 2) * kstep;
            const char* a3 = a2 + kstep; const char* b3 = b2 + kstep;
            PG8_LDB(B0, 0, 0); PG8_LDB(B1, 0, 1); PG8_SCHED; PG8_LDA(At, 0, 0); PG8_STAGEA(PG8_SA(1, 1), a1, 1);
            if constexpr (GATHER) { if (last && has_next) {
                if (nxt.toks) { _Pragma("unroll") for (int _h = 0; _h < 2; ++_h) _Pragma("unroll") for (int _i = 0; _i < 2; ++_i) { int _R, _C; stage_rc(tid * 16 + _i * 8192, _R, _C);
                    vgC[_h][_i] = (unsigned)(tokl[_h * HALF + _R] * lda * ESZ + _C * 2); } }
                else { PG8_GOFF(vgC, nxt); } } }
            PG8_WAIT_V(8); PG8_WAIT_L(0); PG8_BAR; PG8_MMA(0, 0, At, B0); PG8_MMA(0, 1, At, B1); PG8_BAR; PG8_SCHED;
            PG8_LDA(At, 0, 1); PG8_STAGE(PG8_SB(0, 0), b2, voffB); PG8_STAGE(PG8_SB(0, 1), b2 + hstepB, voffB); PG8_STAGEA(PG8_SA(0, 0), a2, 0);
            PG8_WAIT_V(8); PG8_WAIT_L(0); PG8_BAR; PG8_MMA(1, 0, At, B0); PG8_MMA(1, 1, At, B1); PG8_BAR; PG8_SCHED;
            PG8_LDB(B0, 1, 0); PG8_LDB(B1, 1, 1); PG8_SCHED; PG8_LDA(At, 1, 0); PG8_STAGEA(PG8_SA(0, 1), a2, 1);
            PG8_WAIT_V(8); PG8_WAIT_L(0); PG8_BAR; PG8_MMA(0, 0, At, B0); PG8_MMA(0, 1, At, B1); PG8_BAR; PG8_SCHED;
            PG8_LDA(At, 1, 1); PG8_STAGE(PG8_SB(1, 0), b3, voffB); PG8_STAGE(PG8_SB(1, 1), b3 + hstepB, voffB); PG8_STAGEA(PG8_SA(1, 0), a3, 0);
            PG8_WAIT_V(8); PG8_WAIT_L(0); PG8_BAR; PG8_MMA(1, 0, At, B0); PG8_MMA(1, 1, At, B1); PG8_BAR; PG8_SCHED;
        }
        if (wr == 0) PG8_BAR;
        E.bias(has_next ? nxt : cur, wr, wc, fq, binit);
#ifdef PROBE_NOEPI
        if (noepi) {
#pragma unroll
            for (int a = 0; a < 2; ++a)
#pragma unroll
                for (int b = 0; b < 2; ++b)
#pragma unroll
                    for (int m = 0; m < 4; ++m)
#pragma unroll
                        for (int n = 0; n < 2; ++n) asm volatile("" :: "v"(acc[a][b][m][n]));
        } else
#endif
        { int te_ = threadIdx.x; asm volatile("" : "+v"(te_));
          const int we_ = __builtin_amdgcn_readfirstlane(te_ >> 6), le_ = te_ & 63; E(acc, cur, we_ >> 2, we_ & 3, le_ & 15, le_ >> 4); }
        if (!has_next) break;
#pragma unroll
        for (int a = 0; a < 2; ++a)
#pragma unroll
            for (int b = 0; b < 2; ++b)
#pragma unroll
                for (int m = 0; m < 4; ++m)
#pragma unroll
                    for (int n = 0; n < 2; ++n) acc[a][b][m][n] = binit[b][n];
        cur = nxt; cA = nA; cB = nB; ++ui;
        if (wr == 1) PG8_BAR;
    }
    PG8_WAIT_V(0);
    PG8_BAR;
#undef PG8_SA
#undef PG8_SB
#undef PG8_STAGE
#undef PG8_STAGEA
#undef PG8_GOFF
#undef PG8_LDA
#undef PG8_LDB
#undef PG8_MMA
#undef PG8_LD8
#undef PG8_WAIT_V
#undef PG8_WAIT_L
#undef PG8_BAR
#undef PG8_SCHED
}
}
namespace pg8 {
__device__ __forceinline__ float bf_lo(unsigned w) { return __uint_as_float(w << 16); }
__device__ __forceinline__ float bf_hi(unsigned w) { return __uint_as_float(w & 0xffff0000u); }
__device__ __forceinline__ float fast_sigmoid(float x) { return __builtin_amdgcn_rcpf(1.f + __builtin_amdgcn_exp2f(-1.4426950408889634f * x)); }
__device__ __forceinline__ void rope8(f32x4& v0, f32x4& v1, const float (&frq)[4], float pos) {
    float x[8] = {v0[0], v0[1], v0[2], v0[3], v1[0], v1[1], v1[2], v1[3]};
#pragma unroll
    for (int p = 0; p < 4; ++p) {
        float rev = pos * frq[p]; rev = __builtin_amdgcn_fractf(rev);
        const float s = __builtin_amdgcn_sinf(rev), c = __builtin_amdgcn_cosf(rev);
        const float a = x[2 * p], b = x[2 * p + 1];
        x[2 * p] = a * c - b * s; x[2 * p + 1] = b * c + a * s;
    }
    v0 = (f32x4){x[0], x[1], x[2], x[3]}; v1 = (f32x4){x[4], x[5], x[6], x[7]};
}
__device__ __forceinline__ float rope_freq(int idx, int half) {
    return __builtin_amdgcn_exp2f(-(float)idx / (float)half * 13.287712379549449f) * 0.15915494309189535f;
}
__device__ __forceinline__ u32x4 pack8(const f32x4& v0, const f32x4& v1) {
    u32x4 w; w.x = cvt_pk_bf16(v0[0], v0[1]); w.y = cvt_pk_bf16(v0[2], v0[3]); w.z = cvt_pk_bf16(v1[0], v1[1]); w.w = cvt_pk_bf16(v1[2], v1[3]); return w;
}

struct EpiProj {
    static constexpr bool PERM = true;
    bf16_t* proj; const float* b_gate; float* ssq; unsigned char* lat8;
    __device__ __forceinline__ void bias(const Unit& u, int wr, int wc, int fq, f32x4 (&b)[2][2]) const {
        const int cg = u.pn * BM + wc * 32 + 8 * fq - 4352;
#pragma unroll
        for (int bj = 0; bj < 2; ++bj)
#pragma unroll
            for (int n = 0; n < 2; ++n) b[bj][n] = u.pn >= 17 ? *(const f32x4*)(b_gate + cg + bj * HALF + 4 * n) : (f32x4){0.f, 0.f, 0.f, 0.f};
    }
    __device__ __forceinline__ void operator()(const f32x4 (&acc)[2][2][4][2], const Unit& u, int wr, int wc, int fr, int fq) const {
        const int pn = u.pn, row0 = u.row_off + wr * 64 + fr, colt = pn * BM + wc * 32 + 8 * fq;
        const bool t_rot = (pn >= 2 && pn <= 10) || pn == 15 || pn == 16, t_sig = pn >= 17, t_ssq = pn < 3;
        const float scl = (pn == 15 || pn == 16) ? 0.125f : 1.f;
        float frq[2][4];
#pragma unroll
        for (int bj = 0; bj < 2; ++bj) {
            const int cg = colt + bj * HALF; int H = 0, idx0 = 0;
            if (cg >= 640 && cg < 704) { H = 32; idx0 = (cg - 640) >> 1; }
            else if (cg >= 704 && cg < 768) { if (cg - 704 < 32) { H = 16; idx0 = (cg - 704) >> 1; } }
            else if (cg >= 768 && cg < 2816) { H = 64; idx0 = ((cg - 768) & 127) >> 1; }
            else if (cg >= 3840 && cg < 4352) { if (((cg - 3840) & 63) < 32) { H = 16; idx0 = ((cg - 3840) & 63) >> 1; } }
#pragma unroll
            for (int p = 0; p < 4; ++p) frq[bj][p] = H ? rope_freq(idx0 + p, H) : 0.f;
        }
#pragma unroll
        for (int ai = 0; ai < 2; ++ai)
#pragma unroll
            for (int m = 0; m < 4; ++m) {
                const int row = row0 + ai * HALF + m * 16; const float pos = (float)(row & 2047);
                bf16_t* rowp = proj + (size_t)row * 6400 + colt;
#pragma unroll
                for (int bj = 0; bj < 2; ++bj) {
                    f32x4 v0 = acc[ai][bj][m][0], v1 = acc[ai][bj][m][1];
                    if (t_ssq) {
                        float s = (v0[0] * v0[0] + v0[1] * v0[1]) + (v0[2] * v0[2] + v0[3] * v0[3]) + (v1[0] * v1[0] + v1[1] * v1[1]) + (v1[2] * v1[2] + v1[3] * v1[3]);
                        s += __shfl_xor(s, 16); s += __shfl_xor(s, 32);
                        if (fq == 0) ssq[(size_t)row * 24 + pn * 8 + bj * 4 + wc] = s;
                    }
                    if (t_rot) rope8(v0, v1, frq[bj], pos);
                    if (t_sig) {
#pragma unroll
                        for (int j = 0; j < 4; ++j) { v0[j] = fast_sigmoid(v0[j]); v1[j] = fast_sigmoid(v1[j]); } }
                    v0 = v0 * scl; v1 = v1 * scl;
                    *(u32x4*)(rowp + bj * HALF) = pack8(v0, v1);
                    if (pn < 2 || (pn == 2 && bj == 0)) { int w0 = 0, w1 = 0;
                        w0 = __builtin_amdgcn_cvt_pk_fp8_f32(v0[0] * 16.f, v0[1] * 16.f, w0, false); w0 = __builtin_amdgcn_cvt_pk_fp8_f32(v0[2] * 16.f, v0[3] * 16.f, w0, true);
                        w1 = __builtin_amdgcn_cvt_pk_fp8_f32(v1[0] * 16.f, v1[1] * 16.f, w1, false); w1 = __builtin_amdgcn_cvt_pk_fp8_f32(v1[2] * 16.f, v1[3] * 16.f, w1, true);
                        u32x2 w; w.x = (unsigned)w0; w.y = (unsigned)w1; *(u32x2*)(lat8 + (size_t)row * 640 + colt + bj * HALF) = w; }
                }
            }
    }
};

struct EpiMla {
    static constexpr bool PERM = true;
    bf16_t* out; int ldc; const float* ssq; int s0, ns; float invn; int rope;
    __device__ __forceinline__ void bias(const Unit&, int, int, int, f32x4 (&b)[2][2]) const { b[0][0] = b[0][1] = b[1][0] = b[1][1] = (f32x4){0.f, 0.f, 0.f, 0.f}; }
    __device__ __forceinline__ void operator()(const f32x4 (&acc)[2][2][4][2], const Unit& u, int wr, int wc, int fr, int fq) const {
        const int row0 = u.row_off + wr * 64 + fr, colt = u.pn * BM + wc * 32 + 8 * fq;
        float frq[2][4];
#pragma unroll
        for (int bj = 0; bj < 2; ++bj) { const int d = (colt + bj * HALF) % 192; const bool rt = rope && d >= 128;
#pragma unroll
            for (int p = 0; p < 4; ++p) frq[bj][p] = rt ? rope_freq(((d - 128) >> 1) + p, 32) : 0.f; }
#pragma unroll
        for (int ai = 0; ai < 2; ++ai) {
            f32x4 pa[4], pb[4], pc[4];
#pragma unroll
            for (int m = 0; m < 4; ++m) { const f32x4* sp = (const f32x4*)(ssq + (size_t)(row0 + ai * HALF + m * 16) * 24 + s0);
                pa[m] = sp[0]; pb[m] = sp[1]; pc[m] = (ns > 8) ? sp[2] : (f32x4){0.f, 0.f, 0.f, 0.f}; }
#pragma unroll
            for (int m = 0; m < 4; ++m) {
                const int row = row0 + ai * HALF + m * 16; const float pos = (float)(row & 2047);
                const f32x4 a = pa[m], b = pb[m], c = pc[m];
                const float tot = ((a[0] + a[1]) + (a[2] + a[3])) + ((b[0] + b[1]) + (b[2] + b[3])) + ((c[0] + c[1]) + (c[2] + c[3]));
                const float r = __builtin_amdgcn_rsqf(tot * invn + 1e-6f);
                bf16_t* rowp = out + (size_t)row * ldc + colt;
#pragma unroll
                for (int bj = 0; bj < 2; ++bj) {
                    f32x4 v0 = acc[ai][bj][m][0] * r, v1 = acc[ai][bj][m][1] * r;
                    if (rope) rope8(v0, v1, frq[bj], pos);
                    *(u32x4*)(rowp + bj * HALF) = pack8(v0, v1);
                }
            }
            asm volatile("" ::: "memory");
        }
    }
};

struct EpiGate {
    static constexpr bool PERM = true;
    bf16_t* out; const bf16_t* prev; const bf16_t* gate; unsigned char* out8;
    __device__ __forceinline__ void bias(const Unit&, int, int, int, f32x4 (&b)[2][2]) const { b[0][0] = b[0][1] = b[1][0] = b[1][1] = (f32x4){0.f, 0.f, 0.f, 0.f}; }
    __device__ __forceinline__ void operator()(const f32x4 (&acc)[2][2][4][2], const Unit& u, int wr, int wc, int fr, int fq) const {
        const int row0 = u.row_off + wr * 64 + fr, colt = u.pn * BM + wc * 32 + 8 * fq;
#pragma unroll
        for (int ai = 0; ai < 2; ++ai) {
            u32x4 gg[4][2], qq[4][2];
#pragma unroll
            for (int m = 0; m < 4; ++m)
#pragma unroll
                for (int bj = 0; bj < 2; ++bj) { const int row = row0 + ai * HALF + m * 16, col = colt + bj * HALF;
                    gg[m][bj] = *(const u32x4*)(gate + (size_t)row * 6400 + col);
                    qq[m][bj] = prev ? *(const u32x4*)(prev + (size_t)row * 1024 + col) : (u32x4){0u, 0u, 0u, 0u}; }
#pragma unroll
            for (int m = 0; m < 4; ++m)
#pragma unroll
                for (int bj = 0; bj < 2; ++bj) { const int row = row0 + ai * HALF + m * 16, col = colt + bj * HALF;
                    const u32x4 g = gg[m][bj], q = qq[m][bj];
                    f32x4 v0 = acc[ai][bj][m][0], v1 = acc[ai][bj][m][1];
                    v0[0] = fmaf(v0[0], bf_lo(g.x), bf_lo(q.x)); v0[1] = fmaf(v0[1], bf_hi(g.x), bf_hi(q.x)); v0[2] = fmaf(v0[2], bf_lo(g.y), bf_lo(q.y)); v0[3] = fmaf(v0[3], bf_hi(g.y), bf_hi(q.y));
                    v1[0] = fmaf(v1[0], bf_lo(g.z), bf_lo(q.z)); v1[1] = fmaf(v1[1], bf_hi(g.z), bf_hi(q.z)); v1[2] = fmaf(v1[2], bf_lo(g.w), bf_lo(q.w)); v1[3] = fmaf(v1[3], bf_hi(g.w), bf_hi(q.w));
                    if (out8) { int w0 = 0, w1 = 0;
#pragma unroll
                        for (int j = 0; j < 4; ++j) { v0[j] = __builtin_amdgcn_fmed3f(v0[j] * 64.f, -448.f, 448.f); v1[j] = __builtin_amdgcn_fmed3f(v1[j] * 64.f, -448.f, 448.f); }
                        w0 = __builtin_amdgcn_cvt_pk_fp8_f32(v0[0], v0[1], w0, false); w0 = __builtin_amdgcn_cvt_pk_fp8_f32(v0[2], v0[3], w0, true);
                        w1 = __builtin_amdgcn_cvt_pk_fp8_f32(v1[0], v1[1], w1, false); w1 = __builtin_amdgcn_cvt_pk_fp8_f32(v1[2], v1[3], w1, true);
                        u32x2 w; w.x = (unsigned)w0; w.y = (unsigned)w1; *(u32x2*)(out8 + (size_t)row * 1024 + col) = w; }
                    else *(u32x4*)(out + (size_t)row * 1024 + col) = pack8(v0, v1); }
            asm volatile("" ::: "memory");
        }
    }
};

struct EpiX1 {
    static constexpr bool PERM = false;
    const float* x; float* x1; float* ssq1;
    __device__ __forceinline__ void bias(const Unit&, int, int, int, f32x4 (&b)[2][2]) const { b[0][0] = b[0][1] = b[1][0] = b[1][1] = (f32x4){0.f, 0.f, 0.f, 0.f}; }
    __device__ __forceinline__ void operator()(const f32x4 (&acc)[2][2][4][2], const Unit& u, int wr, int wc, int fr, int fq) const {
        const int row0 = u.row_off + wr * 64 + fr, col0 = u.pn * BM + wc * 32 + 4 * fq;
#pragma unroll
        for (int ai = 0; ai < 2; ++ai) {
            f32x4 bs[4][2][2];
#pragma unroll
            for (int m = 0; m < 4; ++m) { const size_t off = (size_t)(row0 + ai * HALF + m * 16) * 1024 + col0;
#pragma unroll
                for (int bj = 0; bj < 2; ++bj)
#pragma unroll
                    for (int n = 0; n < 2; ++n) bs[m][bj][n] = *(const f32x4*)(x + off + bj * HALF + n * 16); }
#pragma unroll
            for (int m = 0; m < 4; ++m) { const int row = row0 + ai * HALF + m * 16; const size_t off = (size_t)row * 1024 + col0; float s = 0.f;
#pragma unroll
                for (int bj = 0; bj < 2; ++bj)
#pragma unroll
                    for (int n = 0; n < 2; ++n) { const f32x4 v = bs[m][bj][n] + acc[ai][bj][m][n]; *(f32x4*)(x1 + off + bj * HALF + n * 16) = v; s += (v[0] * v[0] + v[1] * v[1]) + (v[2] * v[2] + v[3] * v[3]); }
                s += __shfl_xor(s, 16); s += __shfl_xor(s, 32);
                if (fq == 0) ssq1[(size_t)row * 16 + u.pn * 4 + wc] = s; }
            asm volatile("" ::: "memory");
        }
    }
};

struct EpiAct {
    static constexpr bool PERM = true;
    bf16_t* act; const float* bgu;
    __device__ __forceinline__ void bias(const Unit& u, int wr, int wc, int fq, f32x4 (&b)[2][2]) const {
        const float* bg = bgu + (size_t)u.e * 2048 + u.pn * HALF + wc * 32 + 8 * fq;
#pragma unroll
        for (int n = 0; n < 2; ++n) { b[0][n] = *(const f32x4*)(bg + 4 * n); b[1][n] = *(const f32x4*)(bg + 1024 + 4 * n); }
    }
    __device__ __forceinline__ void operator()(const f32x4 (&acc)[2][2][4][2], const Unit& u, int wr, int wc, int fr, int fq) const {
        const int rr0 = wr * 64 + fr, cb = u.pn * HALF + wc * 32 + 8 * fq;
#pragma unroll
        for (int ai = 0; ai < 2; ++ai)
#pragma unroll
            for (int m = 0; m < 4; ++m) {
                const int rr = rr0 + ai * HALF + m * 16;
                f32x4 o[2];
#pragma unroll
                for (int n = 0; n < 2; ++n) { const f32x4 g = acc[ai][0][m][n], l = acc[ai][1][m][n]; f32x4 gt, ln, e;
#pragma unroll
                    for (int j = 0; j < 4; ++j) { gt[j] = __builtin_amdgcn_fmed3f(g[j], -3.0e38f, 7.0f); ln[j] = __builtin_amdgcn_fmed3f(l[j], -7.0f, 7.0f); }
                    e = gt * (-1.702f * 1.4426950408889634f);
#pragma unroll
                    for (int j = 0; j < 4; ++j) e[j] = __builtin_amdgcn_exp2f(e[j]);
                    e = e + 1.0f;
#pragma unroll
                    for (int j = 0; j < 4; ++j) e[j] = __builtin_amdgcn_rcpf(e[j]);
                    o[n] = (ln * 4.0f + 4.0f) * (gt * e); }
                if (rr < u.rows) { int w0 = 0, w1 = 0;
                    w0 = __builtin_amdgcn_cvt_pk_fp8_f32(o[0][0], o[0][1], w0, false); w0 = __builtin_amdgcn_cvt_pk_fp8_f32(o[0][2], o[0][3], w0, true);
                    w1 = __builtin_amdgcn_cvt_pk_fp8_f32(o[1][0], o[1][1], w1, false); w1 = __builtin_amdgcn_cvt_pk_fp8_f32(o[1][2], o[1][3], w1, true);
                    u32x2 w; w.x = (unsigned)w0; w.y = (unsigned)w1; *(u32x2*)((unsigned char*)act + (size_t)(u.row_off + rr) * 1024 + cb) = w; }
            }
    }
};

struct EpiY {
    static constexpr bool PERM = true;
    bf16_t* y; const float* bdn;
    __device__ __forceinline__ void bias(const Unit& u, int wr, int wc, int fq, f32x4 (&b)[2][2]) const {
        const float* bd = bdn + (size_t)u.e * 1024 + u.pn * BM + wc * 32 + 8 * fq;
#pragma unroll
        for (int bj = 0; bj < 2; ++bj)
#pragma unroll
            for (int n = 0; n < 2; ++n) b[bj][n] = *(const f32x4*)(bd + bj * HALF + 4 * n);
    }
    __device__ __forceinline__ void operator()(const f32x4 (&acc)[2][2][4][2], const Unit& u, int wr, int wc, int fr, int fq) const {
        const int rr0 = wr * 64 + fr, colt = u.pn * BM + wc * 32 + 16 * (fq >> 1), odd = fq & 1;
#pragma unroll
        for (int ai = 0; ai < 2; ++ai)
#pragma unroll
            for (int mp = 0; mp < 4; mp += 2) {
                const int rr = rr0 + ai * HALF + (mp + odd) * 16;
#pragma unroll
                for (int bj = 0; bj < 2; ++bj) { unsigned w[2][2];
#pragma unroll
                    for (int d = 0; d < 2; ++d) { const f32x4 v0 = acc[ai][bj][mp + d][0] * 16.f, v1 = acc[ai][bj][mp + d][1] * 16.f; int w0 = 0, w1 = 0;
                        w0 = __builtin_amdgcn_cvt_pk_fp8_f32(v0[0], v0[1], w0, false); w0 = __builtin_amdgcn_cvt_pk_fp8_f32(v0[2], v0[3], w0, true);
                        w1 = __builtin_amdgcn_cvt_pk_fp8_f32(v1[0], v1[1], w1, false); w1 = __builtin_amdgcn_cvt_pk_fp8_f32(v1[2], v1[3], w1, true);
                        w[d][0] = (unsigned)w0; w[d][1] = (unsigned)w1; }
                    const auto s0 = __builtin_amdgcn_permlane16_swap(w[0][0], w[1][0], false, false), s1 = __builtin_amdgcn_permlane16_swap(w[0][1], w[1][1], false, false);
                    if (rr < u.rows) { u32x4 o; o.x = s0[0]; o.y = s1[0]; o.z = s0[1]; o.w = s1[1]; *(u32x4*)((unsigned char*)y + (size_t)(u.row_off + rr) * 1024 + colt + bj * HALF) = o; }
                }
            }
    }
};
}
namespace att {
using bf16 = unsigned short;
using bf16x8 = __attribute__((ext_vector_type(8))) short;
using s16x4  = __attribute__((ext_vector_type(4))) short;
using f32x16 = __attribute__((ext_vector_type(16))) float;
using u32x4  = __attribute__((ext_vector_type(4))) unsigned;
constexpr int D = 128, NW = 8, QBLK = 32, KVBLK = 64;
constexpr float THR = 8.f;
constexpr size_t SHM_V = KVBLK * D * 2, SHM_K = KVBLK * D * 2, SHM_KR = KVBLK * 64 * 2;
constexpr size_t OFF_V = 0, OFF_K = 2 * SHM_V, OFF_KR = OFF_K + 2 * SHM_K, OFF_WS = OFF_KR + 2 * SHM_KR, OFF_QP = OFF_WS + NW * 64 * 4, SHM_ATTN = OFF_QP + NW * 4096;
#define KSWZ(row, colB) ((row) * 256 + ((colB) ^ (((row) & 15) << 4)))
#define KRSWZ(row, colB) ((row) * 128 + ((colB) ^ ((((row) >> 1) & 7) << 4)))
#define SBAR() __builtin_amdgcn_sched_barrier(0)
__device__ __forceinline__ int crow(int r, int hi) { return (r & 3) + 8 * (r >> 2) + 4 * hi; }
__device__ __forceinline__ unsigned cvtpk(float lo, float hi) { unsigned r; asm volatile("v_cvt_pk_bf16_f32 %0, %1, %2" : "=v"(r) : "v"(lo), "v"(hi)); return r; }

__device__ __forceinline__ void apply_mask(f32x16& p0, f32x16& p1, unsigned w) {
    const unsigned NEG = 0xff800000u;
#pragma unroll
    for (int r = 0; r < 16; ++r) {
        const unsigned t0 = (unsigned)__builtin_amdgcn_sbfe((int)w, r, 1), t1 = (unsigned)__builtin_amdgcn_sbfe((int)w, 16 + r, 1);
        p0[r] = __uint_as_float((__float_as_uint(p0[r]) & t0) | (NEG & ~t0));
        p1[r] = __uint_as_float((__float_as_uint(p1[r]) & t1) | (NEG & ~t1));
    }
}
template <int MODE>
__device__ __forceinline__ void partialSM(f32x16& p0, f32x16& p1, float& m_reg, float& mn, float& alpha) {
    constexpr float SCALE = MODE == 0 ? 0.07216878364870322f : 0.08838834764831845f;
    constexpr float C = SCALE * 1.4426950408889634f;
    float pmax = p0[0];
#pragma unroll
    for (int r = 1; r < 16; ++r) pmax = fmaxf(pmax, p0[r]);
#pragma unroll
    for (int r = 0; r < 16; ++r) pmax = fmaxf(pmax, p1[r]);
    { auto rr = __builtin_amdgcn_permlane32_swap(__float_as_uint(pmax), __float_as_uint(pmax), false, false);
      pmax = fmaxf(__uint_as_float(rr[0]), __uint_as_float(rr[1])); }
    if (__builtin_expect(__all(pmax - m_reg <= THR / SCALE), 1)) { mn = m_reg; alpha = 1.f; }
    else { mn = fmaxf(m_reg, pmax); alpha = __builtin_amdgcn_exp2f((m_reg - mn) * C); m_reg = mn; }
    const float mnC = -mn * C;
#pragma unroll
    for (int r = 0; r < 16; ++r) p0[r] = fmaf(p0[r], C, mnC);
#pragma unroll
    for (int r = 0; r < 16; ++r) p1[r] = fmaf(p1[r], C, mnC);
#pragma unroll
    for (int r = 0; r < 16; ++r) p0[r] = __builtin_amdgcn_exp2f(p0[r]);
}
__device__ __forceinline__ void finishSM(f32x16& p0, f32x16& p1, float alpha, float& l_reg, bf16x8& pa0, bf16x8& pa1, bf16x8& pa2, bf16x8& pa3) {
#pragma unroll
    for (int r = 0; r < 16; ++r) p1[r] = __builtin_amdgcn_exp2f(p1[r]);
    float ps = 0;
#pragma unroll
    for (int r = 0; r < 16; ++r) ps += p0[r];
#pragma unroll
    for (int r = 0; r < 16; ++r) ps += p1[r];
    { auto rr = __builtin_amdgcn_permlane32_swap(__float_as_uint(ps), __float_as_uint(ps), false, false);
      ps = __uint_as_float(rr[0]) + __uint_as_float(rr[1]); }
    l_reg = l_reg * alpha + ps;
#define PK4(P, BASE, OUT) do { unsigned a0 = cvtpk(P[BASE + 0], P[BASE + 1]), a1 = cvtpk(P[BASE + 2], P[BASE + 3]);   \
    unsigned b0 = cvtpk(P[BASE + 4], P[BASE + 5]), b1 = cvtpk(P[BASE + 6], P[BASE + 7]);                              \
    auto r0 = __builtin_amdgcn_permlane32_swap(a0, b0, false, false); auto r1 = __builtin_amdgcn_permlane32_swap(a1, b1, false, false); \
    u32x4 w = {r0[0], r1[0], r0[1], r1[1]}; OUT = *reinterpret_cast<bf16x8*>(&w); } while (0)
    PK4(p0, 0, pa0); PK4(p0, 8, pa1); PK4(p1, 0, pa2); PK4(p1, 8, pa3);
#undef PK4
}
template <int MODE>
__device__ __forceinline__ void qkt(f32x16& p0, f32x16& p1, const char* Ks, const char* Krs, const bf16x8* qr, const char* qpark, int r32, int hi) {
    constexpr int NREG = MODE == 0 ? 8 : 6;
    p0 = f32x16{}; p1 = f32x16{};
#pragma unroll
    for (int d0 = 0; d0 < 8; ++d0) { const int cb = (d0 * 16 + hi * 8) * 2;
        bf16x8 b0 = *reinterpret_cast<const bf16x8*>(Ks + KSWZ(r32, cb));
        bf16x8 b1 = *reinterpret_cast<const bf16x8*>(Ks + KSWZ(32 + r32, cb));
        const bf16x8 qv = d0 < NREG ? qr[d0 < NREG ? d0 : 0] : *reinterpret_cast<const bf16x8*>(qpark + (d0 - NREG) * 1024);
        p0 = __builtin_amdgcn_mfma_f32_32x32x16_bf16(b0, qv, p0, 0, 0, 0);
        p1 = __builtin_amdgcn_mfma_f32_32x32x16_bf16(b1, qv, p1, 0, 0, 0); }
    if constexpr (MODE == 0) {
#pragma unroll
        for (int d0 = 0; d0 < 4; ++d0) { const int cb = (d0 * 16 + hi * 8) * 2;
            bf16x8 b0 = *reinterpret_cast<const bf16x8*>(Krs + KRSWZ(r32, cb));
            bf16x8 b1 = *reinterpret_cast<const bf16x8*>(Krs + KRSWZ(32 + r32, cb));
            const bf16x8 qv = *reinterpret_cast<const bf16x8*>(qpark + d0 * 1024);
            p0 = __builtin_amdgcn_mfma_f32_32x32x16_bf16(b0, qv, p0, 0, 0, 0);
            p1 = __builtin_amdgcn_mfma_f32_32x32x16_bf16(b1, qv, p1, 0, 0, 0); }
    }
}
__device__ __forceinline__ int v_st(int k, int c) { const int kk = (k & ~0xC) | ((k & 4) << 1) | ((k & 8) >> 1); return ((kk >> 3) * 4 + (c >> 5)) * 512 + ((kk & 7) * 32 + (c & 31)) * 2; }
__device__ __forceinline__ int v_rd_base(int lane) { return ((lane & 3) << 3) | (((lane >> 2) & 3) << 6) | (((lane >> 4) & 1) << 5) | (((lane >> 5) & 1) << 8); }
constexpr int v_rd_off(int d0, int ks, int half) { return d0 * 512 + ks * 4096 + half * 2048; }
template <int OFF> __device__ __forceinline__ s16x4 tr_read(int vb) {
    s16x4 r; asm volatile("ds_read_b64_tr_b16 %0, %1 offset:%2" : "=&v"(r) : "v"(vb), "i"(OFF) : "memory"); return r;
}
template <int D0> __device__ __forceinline__ void pv_one(f32x16& od, int vb, bf16x8 pa0, bf16x8 pa1, bf16x8 pa2, bf16x8 pa3) {
    const s16x4 l0 = tr_read<v_rd_off(D0, 0, 0)>(vb), h0 = tr_read<v_rd_off(D0, 0, 1)>(vb), l1 = tr_read<v_rd_off(D0, 1, 0)>(vb), h1 = tr_read<v_rd_off(D0, 1, 1)>(vb);
    const s16x4 l2 = tr_read<v_rd_off(D0, 2, 0)>(vb), h2 = tr_read<v_rd_off(D0, 2, 1)>(vb), l3 = tr_read<v_rd_off(D0, 3, 0)>(vb), h3 = tr_read<v_rd_off(D0, 3, 1)>(vb);
    asm volatile("s_waitcnt lgkmcnt(0)" ::: "memory"); SBAR();
#define PK(L, H) (bf16x8){L[0], L[1], L[2], L[3], H[0], H[1], H[2], H[3]}
    od = __builtin_amdgcn_mfma_f32_32x32x16_bf16(pa0, PK(l0, h0), od, 0, 0, 0);
    od = __builtin_amdgcn_mfma_f32_32x32x16_bf16(pa1, PK(l1, h1), od, 0, 0, 0);
    od = __builtin_amdgcn_mfma_f32_32x32x16_bf16(pa2, PK(l2, h2), od, 0, 0, 0);
    od = __builtin_amdgcn_mfma_f32_32x32x16_bf16(pa3, PK(l3, h3), od, 0, 0, 0);
#undef PK
}
__device__ __forceinline__ void pv_d0(f32x16* o, int vb, bf16x8 pa0, bf16x8 pa1, bf16x8 pa2, bf16x8 pa3) {
    pv_one<0>(o[0], vb, pa0, pa1, pa2, pa3); pv_one<1>(o[1], vb, pa0, pa1, pa2, pa3); pv_one<2>(o[2], vb, pa0, pa1, pa2, pa3); pv_one<3>(o[3], vb, pa0, pa1, pa2, pa3);
}

template <int MODE, int LDQ, int LDK>
__device__ __forceinline__ void attn_unit(const bf16* __restrict__ Qb, const bf16* __restrict__ Kh, const bf16* __restrict__ Vh, const bf16* __restrict__ Krh,
                                          const unsigned* __restrict__ Mk, unsigned char* __restrict__ Ob, int i0, char* lds) {
    constexpr int NQ = MODE == 0 ? 12 : 8;
    int tid_ = threadIdx.x; asm volatile("" : "+v"(tid_));
    const int tid = tid_, wid = __builtin_amdgcn_readfirstlane(tid >> 6), lane = tid & 63, r32 = lane & 31, hi = lane >> 5;
    char* V_lds = lds + OFF_V; char* K_lds = lds + OFF_K; char* Kr_lds = lds + OFF_KR;
    float* ws = (float*)(lds + OFF_WS) + wid * 64; float* li_l = ws; float* al_l = ws + 32;
    constexpr int NREG = MODE == 0 ? 8 : 6;
    float m_reg = -1e30f, l_reg = 0; f32x16 o[4] = {}; bf16x8 qr[NREG];
    const bf16* Qw = Qb + (long)(wid * QBLK + r32) * LDQ + hi * 8;
    char* qpark = lds + OFF_QP + wid * 4096 + lane * 16;
#pragma unroll
    for (int d0 = 0; d0 < NREG; ++d0) qr[d0] = *reinterpret_cast<const bf16x8*>(Qw + d0 * 16);
#pragma unroll
    for (int d0 = NREG; d0 < NQ; ++d0) *reinterpret_cast<bf16x8*>(qpark + (d0 - NREG) * 1024) = *reinterpret_cast<const bf16x8*>(Qw + d0 * 16);
    const int sr = tid >> 4, sc = (tid & 15) * 8, vst0 = v_st(sr, sc), vst1 = v_st(32 + sr, sc);
    const int krr = tid >> 3, krc = (tid & 7) * 8;
    const int vb0 = (int)(uintptr_t)V_lds + v_rd_base(lane);
    const int NT = (i0 + 256) / KVBLK;
    const int jvis = (i0 >> 6) + (wid >> 1);
    const unsigned* Mw = Mk + ((size_t)(wid * QBLK + r32) * 32) * 2 + hi;
    struct { bf16x8 vs0, vs1, ks0, ks1, kr; } st;
#define SLOAD(k0) do { st.vs0 = *reinterpret_cast<const bf16x8*>(&Vh[(long)((k0) + sr) * LDK + sc]); st.vs1 = *reinterpret_cast<const bf16x8*>(&Vh[(long)((k0) + 32 + sr) * LDK + sc]); \
    st.ks0 = *reinterpret_cast<const bf16x8*>(&Kh[(long)((k0) + sr) * LDK + sc]); st.ks1 = *reinterpret_cast<const bf16x8*>(&Kh[(long)((k0) + 32 + sr) * LDK + sc]); \
    if constexpr (MODE == 0) st.kr = *reinterpret_cast<const bf16x8*>(&Krh[(long)((k0) + krr) * 6400 + krc]); } while (0)
#define SWRITE(b) do { *(bf16x8*)(V_lds + (b) * SHM_V + vst0) = st.vs0; *(bf16x8*)(V_lds + (b) * SHM_V + vst1) = st.vs1; const int kc = sc * 2; \
    *(bf16x8*)(K_lds + (b) * SHM_K + KSWZ(sr, kc)) = st.ks0; *(bf16x8*)(K_lds + (b) * SHM_K + KSWZ(32 + sr, kc)) = st.ks1; \
    if constexpr (MODE == 0) *(bf16x8*)(Kr_lds + (b) * SHM_KR + KRSWZ(krr, krc * 2)) = st.kr; } while (0)
#define RESC(a) do { if (__any((a) < 1.f)) { if (hi == 0) al_l[r32] = (a); asm volatile("s_waitcnt lgkmcnt(0)" ::: "memory"); \
    _Pragma("unroll") for (int d = 0; d < 4; ++d) _Pragma("unroll") for (int r = 0; r < 16; ++r) o[d][r] *= al_l[crow(r, hi)]; } } while (0)
#define MASKT(P0, P1, j, MWORD) do { if constexpr (MODE == 0) { if ((j) > jvis) { asm volatile("" ::: "memory");   \
        _Pragma("unroll") for (int r = 0; r < 16; ++r) { P0[r] = -INFINITY; P1[r] = -INFINITY; } } } \
    else { apply_mask(P0, P1, MWORD); } } while (0)
#define MLOAD(j) (MODE == 1 ? Mw[(j) * 2] : 0u)
    f32x16 pA0, pA1, pB0, pB1; float mnA, mnB, alA, alB; bf16x8 pa0, pa1, pa2, pa3;
    SLOAD(0); asm volatile("s_waitcnt vmcnt(0)" ::: "memory"); SWRITE(0); __syncthreads();
    unsigned mwA = MLOAD(0), mwB = MLOAD(1);
    qkt<MODE>(pA0, pA1, K_lds, Kr_lds, qr, qpark, r32, hi); MASKT(pA0, pA1, 0, mwA); partialSM<MODE>(pA0, pA1, m_reg, mnA, alA);
    SLOAD(KVBLK);
    SWRITE(1); __syncthreads();
    for (int j = 1; j + 1 < NT; j += 2) {
        SBAR(); qkt<MODE>(pB0, pB1, K_lds + SHM_K, Kr_lds + SHM_KR, qr, qpark, r32, hi);
        finishSM(pA0, pA1, alA, l_reg, pa0, pa1, pa2, pa3); SBAR();
        SLOAD((j + 1) * KVBLK); mwA = MLOAD(j + 1); SBAR();
        pv_d0(o, vb0, pa0, pa1, pa2, pa3); MASKT(pB0, pB1, j, mwB); partialSM<MODE>(pB0, pB1, m_reg, mnB, alB);
        __syncthreads(); SWRITE(0);
        RESC(alB); __syncthreads();
        SBAR(); qkt<MODE>(pA0, pA1, K_lds, Kr_lds, qr, qpark, r32, hi);
        finishSM(pB0, pB1, alB, l_reg, pa0, pa1, pa2, pa3); SBAR();
        SLOAD((j + 2) * KVBLK); mwB = MLOAD(j + 2); SBAR();
        pv_d0(o, vb0 + (int)SHM_V, pa0, pa1, pa2, pa3); MASKT(pA0, pA1, j + 1, mwA); partialSM<MODE>(pA0, pA1, m_reg, mnA, alA);
        __syncthreads(); SWRITE(1);
        RESC(alA); __syncthreads();
    }
    SBAR(); qkt<MODE>(pB0, pB1, K_lds + SHM_K, Kr_lds + SHM_KR, qr, qpark, r32, hi);
    finishSM(pA0, pA1, alA, l_reg, pa0, pa1, pa2, pa3); SBAR();
    pv_d0(o, vb0, pa0, pa1, pa2, pa3); MASKT(pB0, pB1, NT - 1, mwB); partialSM<MODE>(pB0, pB1, m_reg, mnB, alB);
    __syncthreads(); RESC(alB);
    finishSM(pB0, pB1, alB, l_reg, pa0, pa1, pa2, pa3); SBAR();
    pv_d0(o, vb0 + (int)SHM_V, pa0, pa1, pa2, pa3);
    if (hi == 0) li_l[r32] = l_reg; asm volatile("s_waitcnt lgkmcnt(0)" ::: "memory");
    unsigned char* Ow = Ob + (long)(wid * QBLK) * 2048;
    const int qi = lane & 3;
    const unsigned selA = (qi & 1) ? 0x03070105u : 0x06020400u, selB = (qi & 2) ? 0x03020706u : 0x05040100u;
#pragma unroll
    for (int rg = 0; rg < 4; ++rg) {
        float rinv[4];
#pragma unroll
        for (int k = 0; k < 4; ++k) rinv[k] = 32.f * __builtin_amdgcn_rcpf(li_l[crow(4 * rg + k, hi)]);
        unsigned char* orow = Ow + (long)(8 * rg + 4 * hi + qi) * 2048 + (r32 & ~3);
#pragma unroll
        for (int d0 = 0; d0 < 4; ++d0) {
            int w = 0;
            w = __builtin_amdgcn_cvt_pk_fp8_f32(o[d0][4 * rg] * rinv[0], o[d0][4 * rg + 1] * rinv[1], w, false);
            w = __builtin_amdgcn_cvt_pk_fp8_f32(o[d0][4 * rg + 2] * rinv[2], o[d0][4 * rg + 3] * rinv[3], w, true);
            const unsigned p1 = (unsigned)__builtin_amdgcn_update_dpp(0, w, 0xB1, 0xf, 0xf, true);
            const unsigned wa = __builtin_amdgcn_perm(p1, (unsigned)w, selA);
            const unsigned p2 = (unsigned)__builtin_amdgcn_update_dpp(0, (int)wa, 0x4E, 0xf, 0xf, true);
            *(unsigned*)(orow + d0 * 32) = __builtin_amdgcn_perm(p2, wa, selB);
        }
    }
    __syncthreads();
#undef SLOAD
#undef SWRITE
#undef RESC
#undef MASKT
#undef MLOAD
}
}
namespace idx {
using bf16 = unsigned short;
using bf16x8 = __attribute__((ext_vector_type(8))) short;
using f32x4 = __attribute__((ext_vector_type(4))) float;
using u32x4 = __attribute__((ext_vector_type(4))) unsigned;
using u32x2 = __attribute__((ext_vector_type(2))) unsigned;
constexpr int ROWW = 2052;
constexpr int LDS_BYTES = 16 * ROWW * 4;
#define IDX_LAS __attribute__((address_space(3)))

__device__ __forceinline__ float funkey(unsigned k) { return __uint_as_float((k & 0x80000000u) ? (k ^ 0x80000000u) : ~k); }
__device__ __forceinline__ unsigned fkey(float f) { const unsigned u = __float_as_uint(f + 0.0f); return u ^ ((unsigned)((int)u >> 31) | 0x80000000u); }
__device__ __forceinline__ void cnt_ge(unsigned& cnt, unsigned key, unsigned ref) { asm("v_cmp_ge_u32 vcc, %1, %2\n\tv_addc_co_u32 %0, vcc, 0, %0, vcc" : "+v"(cnt) : "v"(key), "v"(ref) : "vcc"); }
__device__ __forceinline__ void cnt_gt(unsigned& cnt, unsigned key, unsigned ref) { asm("v_cmp_gt_u32 vcc, %1, %2\n\tv_addc_co_u32 %0, vcc, 0, %0, vcc" : "+v"(cnt) : "v"(key), "v"(ref) : "vcc"); }
__device__ __forceinline__ void cnt_eq(unsigned& cnt, unsigned key, unsigned ref) { asm("v_cmp_eq_u32 vcc, %1, %2\n\tv_addc_co_u32 %0, vcc, 0, %0, vcc" : "+v"(cnt) : "v"(key), "v"(ref) : "vcc"); }
__device__ __forceinline__ void cnt_ge4(unsigned& c0, unsigned& c1, unsigned& c2, unsigned& c3, unsigned k0, unsigned k1, unsigned k2, unsigned k3, unsigned ref) {
    asm("v_cmp_ge_u32 s[70:71], %4, %8\n\tv_cmp_ge_u32 s[72:73], %5, %8\n\tv_cmp_ge_u32 s[74:75], %6, %8\n\tv_cmp_ge_u32 vcc, %7, %8\n\t"
        "v_addc_co_u32 %0, s[70:71], 0, %0, s[70:71]\n\tv_addc_co_u32 %1, s[72:73], 0, %1, s[72:73]\n\tv_addc_co_u32 %2, s[74:75], 0, %2, s[74:75]\n\tv_addc_co_u32 %3, vcc, 0, %3, vcc"
        : "+v"(c0), "+v"(c1), "+v"(c2), "+v"(c3) : "v"(k0), "v"(k1), "v"(k2), "v"(k3), "v"(ref) : "vcc", "s70", "s71", "s72", "s73", "s74", "s75");
}
#define IDX_DPP(v, ctrl) ((unsigned)__builtin_amdgcn_update_dpp(0, (int)(v), ctrl, 0xf, 0xf, true))
__device__ __forceinline__ unsigned half_sum(unsigned v) {
    v += IDX_DPP(v, 0xB1); v += IDX_DPP(v, 0x4E); v += IDX_DPP(v, 0x141); v += IDX_DPP(v, 0x140); { auto r = __builtin_amdgcn_permlane16_swap(v, v, false, false); v = r[0] + r[1]; } return v;
}
__device__ __forceinline__ unsigned half_min(unsigned v) {
    v = min(v, IDX_DPP(v, 0xB1)); v = min(v, IDX_DPP(v, 0x4E)); v = min(v, IDX_DPP(v, 0x141)); v = min(v, IDX_DPP(v, 0x140)); { auto r = __builtin_amdgcn_permlane16_swap(v, v, false, false); v = min(r[0], r[1]); } return v;
}
__device__ __forceinline__ unsigned half_max(unsigned v) {
    v = max(v, IDX_DPP(v, 0xB1)); v = max(v, IDX_DPP(v, 0x4E)); v = max(v, IDX_DPP(v, 0x141)); v = max(v, IDX_DPP(v, 0x140)); { auto r = __builtin_amdgcn_permlane16_swap(v, v, false, false); v = max(r[0], r[1]); } return v;
}

struct Conv { const float* wgu; const float* wdn; bf16* wgu_t; bf16* wdn_t; };
__device__ __forceinline__ unsigned f2bf_(float f) { const unsigned u = __float_as_uint(f); return (u + 0x7fffu + ((u >> 16) & 1u)) >> 16; }
struct ConvBuf { float v[8][8]; unsigned char* dst; };
__device__ __forceinline__ void conv_load(ConvBuf& B, const Conv& cv, int st, int lane) {
    const float* W; bf16* WT; int nsrc, srcc, nb, kb;
    if (st < 16384) { const int e = st >> 9, r = st & 511; kb = r >> 5; nb = r & 31; W = cv.wgu + (size_t)e * 1024 * 2048; WT = (bf16*)((unsigned char*)cv.wgu_t + (size_t)e * 2048 * 1024); nsrc = 2048;
        const int n = 64 * nb, pn = n >> 8, wth = n & 255; srcc = wth < 128 ? 128 * pn + wth : 1024 + 128 * pn + (wth - 128); }
    else { const int s2 = st - 16384, e = s2 >> 8, r = s2 & 255; kb = r >> 4; nb = r & 15; W = cv.wdn + (size_t)e * 1024 * 1024; WT = (bf16*)((unsigned char*)cv.wdn_t + (size_t)e * 1024 * 1024); nsrc = 1024; srcc = 64 * nb; }
    const float* src = W + (size_t)(64 * kb) * nsrc + srcc + lane;
    B.dst = (unsigned char*)WT + (size_t)(64 * nb + lane) * 1024 + 64 * kb;
#pragma unroll
    for (int s = 0; s < 8; ++s)
#pragma unroll
        for (int k = 0; k < 8; ++k) B.v[s][k] = src[(size_t)(8 * s + k) * nsrc];
}
__device__ __forceinline__ void conv_store(const ConvBuf& B) {
#pragma unroll
    for (int s = 0; s < 8; ++s) { int w0 = 0, w1 = 0;
        w0 = __builtin_amdgcn_cvt_pk_fp8_f32(B.v[s][0] * 64.f, B.v[s][1] * 64.f, w0, false); w0 = __builtin_amdgcn_cvt_pk_fp8_f32(B.v[s][2] * 64.f, B.v[s][3] * 64.f, w0, true);
        w1 = __builtin_amdgcn_cvt_pk_fp8_f32(B.v[s][4] * 64.f, B.v[s][5] * 64.f, w1, false); w1 = __builtin_amdgcn_cvt_pk_fp8_f32(B.v[s][6] * 64.f, B.v[s][7] * 64.f, w1, true);
        u32x2 o; o.x = (unsigned)w0; o.y = (unsigned)w1; *(u32x2*)(B.dst + 8 * s) = o; }
}
__device__ __forceinline__ void conv_super(const Conv& cv, int st, int lane) { ConvBuf B; conv_load(B, cv, st, lane); conv_store(B); }
struct ConvH { float v[4][8]; unsigned char* dst; };
__device__ __forceinline__ void conv_load_h(ConvH& B, const Conv& cv, int st, int hf, int lane) {
    const float* W; bf16* WT; int nsrc, srcc, nb, kb;
    if (st < 16384) { const int e = st >> 9, r = st & 511; kb = r >> 5; nb = r & 31; W = cv.wgu + (size_t)e * 1024 * 2048; WT = (bf16*)((unsigned char*)cv.wgu_t + (size_t)e * 2048 * 1024); nsrc = 2048;
        const int n = 64 * nb, pn = n >> 8, wth = n & 255; srcc = wth < 128 ? 128 * pn + wth : 1024 + 128 * pn + (wth - 128); }
    else { const int s2 = st - 16384, e = s2 >> 8, r = s2 & 255; kb = r >> 4; nb = r & 15; W = cv.wdn + (size_t)e * 1024 * 1024; WT = (bf16*)((unsigned char*)cv.wdn_t + (size_t)e * 1024 * 1024); nsrc = 1024; srcc = 64 * nb; }
    const float* src = W + (size_t)(64 * kb + 32 * hf) * nsrc + srcc + lane;
    B.dst = (unsigned char*)WT + (size_t)(64 * nb + lane) * 1024 + 64 * kb + 32 * hf;
#pragma unroll
    for (int s = 0; s < 4; ++s)
#pragma unroll
        for (int k = 0; k < 8; ++k) B.v[s][k] = src[(size_t)(8 * s + k) * nsrc];
}
__device__ __forceinline__ void conv_store_h(const ConvH& B) {
#pragma unroll
    for (int s = 0; s < 4; ++s) { int w0 = 0, w1 = 0;
        w0 = __builtin_amdgcn_cvt_pk_fp8_f32(B.v[s][0] * 64.f, B.v[s][1] * 64.f, w0, false); w0 = __builtin_amdgcn_cvt_pk_fp8_f32(B.v[s][2] * 64.f, B.v[s][3] * 64.f, w0, true);
        w1 = __builtin_amdgcn_cvt_pk_fp8_f32(B.v[s][4] * 64.f, B.v[s][5] * 64.f, w1, false); w1 = __builtin_amdgcn_cvt_pk_fp8_f32(B.v[s][6] * 64.f, B.v[s][7] * 64.f, w1, true);
        u32x2 o; o.x = (unsigned)w0; o.y = (unsigned)w1; *(u32x2*)(B.dst + 8 * s) = o; }
}
__device__ __forceinline__ void index_unit(const bf16* __restrict__ proj, const float* __restrict__ widx, unsigned* __restrict__ mask, int b, int qg, IDX_LAS unsigned char* lds,
                                           const Conv& cv, int tbase, int quota) {
    int tid_ = threadIdx.x; asm volatile("" : "+v"(tid_));
    const int tid = tid_, w = __builtin_amdgcn_readfirstlane(tid >> 6), lane = tid & 63;
    const int c = qg >> 2;
    ConvH H0, H1, H2;
#define CONV_ISSUE() do { if (quota) { conv_load_h(H0, cv, tbase + ((3 * w) >> 1), (3 * w) & 1, lane); conv_load_h(H1, cv, tbase + ((3 * w + 1) >> 1), (3 * w + 1) & 1, lane); \
                                        conv_load_h(H2, cv, tbase + ((3 * w + 2) >> 1), (3 * w + 2) & 1, lane); } } while (0)
#define CONV_RETIRE() do { if (quota) { conv_store_h(H0); conv_store_h(H1); conv_store_h(H2); } } while (0)
    IDX_LAS unsigned* kl = (IDX_LAS unsigned*)lds;
    const int j = lane & 31;
    if (c >= 4) {
        REPS(20) {
            const int q = lane & 15, g = lane >> 4;
            const size_t trow = (size_t)b * 2048 + 16 * qg + q;
            bf16x8 bq[8][2]; float wi[8];
            const bf16* qp = proj + trow * 6400 + 3840 + 8 * g;
#pragma unroll
            for (int h = 0; h < 8; ++h) { bq[h][0] = *reinterpret_cast<const bf16x8*>(qp + h * 64); bq[h][1] = *reinterpret_cast<const bf16x8*>(qp + h * 64 + 32); }
            { const f32x4 a0 = *(const f32x4*)(widx + trow * 8), a1 = *(const f32x4*)(widx + trow * 8 + 4);
              wi[0] = a0[0]; wi[1] = a0[1]; wi[2] = a0[2]; wi[3] = a0[3]; wi[4] = a1[0]; wi[5] = a1[1]; wi[6] = a1[2]; wi[7] = a1[3]; }
            bf16x8 ak[2][4][2];
            const bf16* kbase = proj + ((size_t)b * 2048 + q) * 6400 + 704 + 8 * g;
#define IDX_LOADK(buf, jj) do { _Pragma("unroll") for (int t = 0; t < 4; ++t) { const bf16* kp = kbase + (size_t)(64 * (jj) + 16 * t) * 6400; \
                ak[buf][t][0] = *reinterpret_cast<const bf16x8*>(kp); ak[buf][t][1] = *reinterpret_cast<const bf16x8*>(kp + 32); } } while (0)
            if (w <= c) IDX_LOADK(0, w);
#pragma unroll
            for (int s = 0; s < 4; ++s) {
                const int jt = w + 8 * s;
                __builtin_amdgcn_sched_barrier(0);
                if (s < 3) { if (jt + 8 <= c) IDX_LOADK((s + 1) & 1, jt + 8); }
                __builtin_amdgcn_sched_barrier(0);
                if (jt <= c) {
#pragma unroll
                    for (int t = 0; t < 4; ++t) {
                        f32x4 sc = {0.f, 0.f, 0.f, 0.f};
#pragma unroll
                        for (int h = 0; h < 8; ++h) {
                            f32x4 acc = {0.f, 0.f, 0.f, 0.f};
                            acc = __builtin_amdgcn_mfma_f32_16x16x32_bf16(ak[s & 1][t][0], bq[h][0], acc, 0, 0, 0);
                            acc = __builtin_amdgcn_mfma_f32_16x16x32_bf16(ak[s & 1][t][1], bq[h][1], acc, 0, 0, 0);
#pragma unroll
                            for (int r = 0; r < 4; ++r) sc[r] = fmaf(wi[h], __int_as_float(max(__float_as_int(acc[r]), 0)), sc[r]);
                        }
                        u32x4 kv; kv.x = fkey(sc[0]); kv.y = fkey(sc[1]); kv.z = fkey(sc[2]); kv.w = fkey(sc[3]);
                        *(IDX_LAS u32x4*)(kl + q * ROWW + 64 * jt + 4 * (4 * t + g)) = kv;
                    }
                }
            }
#undef IDX_LOADK
        }
        __syncthreads();
        CONV_ISSUE();
        {
            const int qq = 2 * w + (lane >> 5); unsigned w0, w1;
            const int nkeys = 64 * (c + 1), nch = (nkeys + 127) >> 7;
            unsigned key[16][4];
#pragma unroll
            for (int i = 0; i < 16; ++i) {
                u32x4 kv = {0u, 0u, 0u, 0u};
                if (i < nch) { if (128 * i + 4 * j < nkeys) kv = *(const IDX_LAS u32x4*)(kl + qq * ROWW + 128 * i + 4 * j); }
                key[i][0] = kv.x; key[i][1] = kv.y; key[i][2] = kv.z; key[i][3] = kv.w;
            }
            unsigned kmin = 0xffffffffu, kmax = 0u;
#pragma unroll
            for (int i = 0; i < 16; ++i)
                if (i < nch) {
                    const bool ok = 128 * i + 4 * j < nkeys;
#pragma unroll
                    for (int r = 0; r < 4; ++r) { kmin = min(kmin, ok ? key[i][r] : 0xffffffffu); kmax = max(kmax, key[i][r]); }
                }
            kmin = half_min(kmin); kmax = half_max(kmax);
            unsigned lo = kmin, hi = kmax + 1u;
            float flo = (float)(nkeys - 256), fhi = -256.f;
            unsigned clo = (unsigned)nkeys, chi = 0u;
            int side = 0; bool done = false;
#pragma unroll 1
            for (int it = 0; ; ++it) {
                unsigned cand;
                if (hi - lo <= 1u) { done = true; cand = lo; }
                else if (it >= 24) cand = lo + ((hi - lo) >> 1);
                else {
                    const float vlo = funkey(lo), vhi = funkey(hi - 1u);
                    const float fr = (flo - fhi <= 6.f && (it & 1)) ? 0.5f : flo * __builtin_amdgcn_rcpf(flo - fhi);
                    cand = fkey(vlo + (vhi - vlo) * fr);
                    cand = cand <= lo ? lo + 1u : cand; cand = cand >= hi ? hi - 1u : cand;
                }
                if (__all(done)) break;
                unsigned c0 = 0, c1 = 0, c2 = 0, c3 = 0;
#pragma unroll
                for (int i = 0; i < 16; i += 2) if (i < nch) { cnt_ge4(c0, c1, c2, c3, key[i][0], key[i][1], key[i][2], key[i][3], cand);
                                                               cnt_ge4(c0, c1, c2, c3, key[i + 1][0], key[i + 1][1], key[i + 1][2], key[i + 1][3], cand); }
                const unsigned tot = half_sum((c0 + c1) + (c2 + c3));
                if (!done) {
                    const float f = (float)((int)tot - 256);
                    if (tot >= 256u) { lo = cand; flo = f; clo = tot; if (side == 1) fhi *= 0.5f; side = 1; }
                    else             { hi = cand; fhi = f; chi = tot; if (side == 2) flo *= 0.5f; side = 2; }
                    if (tot == 256u) done = true;
                }
            }
            const unsigned T = lo;
            const int need = (clo == 256u) ? 0x7fffffff : 256 - (int)chi;
            const bool tie = __any(clo > 256u);
            IDX_LAS unsigned* mw = (IDX_LAS unsigned*)(lds + LDS_BYTES) + qq * 64;
            *(IDX_LAS u32x2*)(mw + 2 * j) = (u32x2){0u, 0u};
            const int hi_ = j & 1, sh_ = 16 * ((j >> 3) & 1) + 4 * ((j >> 1) & 3);
            int base = 0;
#pragma unroll
            for (int i = 0; i < 16; ++i)
                if (i < nch) {
                    unsigned nib = 0;
                    if (!tie) {
#pragma unroll
                        for (int r = 0; r < 4; ++r) nib |= (key[i][r] >= T) ? (1u << r) : 0u;
                    } else {
                        int e = 0;
#pragma unroll
                        for (int r = 0; r < 4; ++r) e += (key[i][r] == T) ? 1 : 0;
                        int incl = e;
#pragma unroll
                        for (int d = 1; d < 32; d <<= 1) { const int t = __shfl_up(incl, d, 32); if (j >= d) incl += t; }
                        int run = base + incl - e;
                        base += __shfl(incl, 31, 32);
#pragma unroll
                        for (int r = 0; r < 4; ++r) { const unsigned k = key[i][r]; const bool eq = (k == T); const bool sel = (k > T) || (eq && run < need); run += eq ? 1 : 0; nib |= sel ? (1u << r) : 0u; }
                    }
                    if (nib) (void)__hip_atomic_fetch_or(mw + (2 * i + (j >> 4)) * 2 + hi_, nib << sh_, __ATOMIC_RELAXED, __HIP_MEMORY_SCOPE_WORKGROUP);
                }
            asm volatile("s_waitcnt lgkmcnt(0)" ::: "memory");
            { const u32x2 o = *(const IDX_LAS u32x2*)(mw + 2 * j); w0 = o.x; w1 = o.y; }
            { u32x2 o; o.x = w0; o.y = w1; *(u32x2*)(mask + (((size_t)b * 2048 + 16 * qg + qq) * 32 + j) * 2) = o; }
        }
        CONV_RETIRE();
    } else {
        __syncthreads();
        CONV_ISSUE();
        {
            const int qq = 2 * w + (lane >> 5);
            u32x2 o; o.x = j <= c ? 0xffffffffu : 0u; o.y = o.x; *(u32x2*)(mask + (((size_t)b * 2048 + 16 * qg + qq) * 32 + j) * 2) = o;
        }
        CONV_RETIRE();
    }
    __syncthreads();
#undef CONV_ISSUE
#undef CONV_RETIRE
}
}
constexpr int NWAVES = 8;
constexpr int T = 32768, SEQ = 2048, NB = 16, DM = 1024, PP = 6400;
constexpr size_t MiB = 1u << 20;
constexpr size_t WS_CTL = 0, CTL_ZERO_BYTES = 64 * 1024;
constexpr size_t WS_WIDX = 1 * MiB;
constexpr size_t WS_SSQ  = 2 * MiB;
constexpr size_t WS_PICK = 5 * MiB;
constexpr size_t WS_WRH  = 5 * MiB + 512 * 1024;
constexpr size_t WS_MASK = 6 * MiB;
constexpr size_t WS_TOK  = 14 * MiB;
constexpr size_t WS_GATE = 18 * MiB;
constexpr size_t WS_WIN  = 22 * MiB;
constexpr size_t WS_WUQ  = WS_WIN + (size_t)6400 * 1024 * 2;
constexpr size_t WS_WUK  = WS_WUQ + (size_t)1536 * 384 * 2;
constexpr size_t WS_WUV  = WS_WUK + (size_t)1024 * 256 * 2;
constexpr size_t WS_WOA  = WS_WUV + (size_t)1024 * 256 * 2;
constexpr size_t WS_WOB  = WS_WOA + (size_t)1024 * 1024 * 2;
constexpr size_t WS_WOUT = WS_WOB + (size_t)1024 * 1024 * 2;
constexpr size_t WS_WGU  = 44 * MiB;
constexpr size_t WS_W8   = 108 * MiB;
constexpr size_t WS_WIN8 = WS_W8, WS_WOA8 = WS_W8 + 7 * MiB, WS_WOB8 = WS_W8 + 8 * MiB, WS_WOUT8 = WS_W8 + 9 * MiB, WS_WUQ8 = WS_W8 + 10 * MiB, WS_WUK8 = WS_W8 + 11 * MiB, WS_WUV8 = WS_WUK8 + 512 * 1024;
constexpr size_t WS_WDN  = 172 * MiB;
constexpr size_t WS_RA   = 236 * MiB;
constexpr size_t WS_RB   = 364 * MiB;
constexpr size_t WS_RC   = 764 * MiB;
constexpr size_t WS_END  = 1020 * MiB;
static_assert(WS_WOUT + (size_t)1024 * 1024 * 2 <= WS_WGU, "ws map");
constexpr size_t RC_Q = 0, RC_K = (size_t)T * 1536 * 2, RC_V = RC_K + (size_t)T * 1024 * 2;
constexpr size_t RC_MA = 0, RC_MG = (size_t)T * 1024 * 2;
constexpr int CW_BAR = 1024;
constexpr int CW_CNT = 8192;
constexpr int RING_BYTES = 131072, LDSCTL_OFF = 139264, MISC_OFF = LDSCTL_OFF + 320, TAB_OFF = LDSCTL_OFF + 1024  , LDS_BYTES = 147456;

#define GAS __attribute__((address_space(1)))
#define LAS __attribute__((address_space(3)))
typedef unsigned short bf16;
typedef unsigned v4u __attribute__((ext_vector_type(4)));
typedef unsigned v2u __attribute__((ext_vector_type(2)));
typedef float f32x4 __attribute__((ext_vector_type(4)));
#define LDS_WAIT() asm volatile("s_waitcnt lgkmcnt(0)" ::: "memory")
#define VM_WAIT() asm volatile("s_waitcnt vmcnt(0)" ::: "memory")
__device__ __forceinline__ unsigned f2bf(float f) { unsigned u = __builtin_bit_cast(unsigned, f); return (u + 0x7fffu + ((u >> 16) & 1u)) >> 16; }
__device__ __forceinline__ unsigned pk2(float lo, float hi) { return f2bf(lo) | (f2bf(hi) << 16); }

#define XB_TMO      128
#define XB_XCNT(j)  (256  + 64 * (j))
#define XB_XSUB(j)  (1280 + 64 * (j))
#define XB_XGEN(j)  (2304 + 64 * (j))
#define XB_TOP      3328
#define XB_TOPGEN   3392
#define XCD_BAR_WORDS 3456
#define XB_SPIN_CAP (1u << 25)
__device__ __forceinline__ unsigned xb_ld(unsigned* p)              { return __hip_atomic_load(p, __ATOMIC_RELAXED, __HIP_MEMORY_SCOPE_AGENT); }
__device__ __forceinline__ unsigned xb_add(unsigned* p, unsigned v) { return __hip_atomic_fetch_add(p, v, __ATOMIC_RELAXED, __HIP_MEMORY_SCOPE_AGENT); }
__device__ __forceinline__ unsigned xb_xcc_id() { return (unsigned)__builtin_amdgcn_s_getreg((3 << 11) | 20) & 0xFu; }
#define XB_SPIN(cond, bar) do { unsigned _sp = 0; while (cond) { __builtin_amdgcn_s_sleep(1); \
    if ((++_sp & 255u) == 0u) { if (xb_ld(&(bar)[XB_TMO])) break; if (_sp > XB_SPIN_CAP) { atomicAdd(&(bar)[XB_TMO], 1u); break; } } } } while (0)
struct XcdBarrier { unsigned* bar; unsigned x; volatile LAS unsigned* st; };
__device__ __forceinline__ XcdBarrier xcd_barrier_post(unsigned* bar, volatile LAS unsigned* st) {
    XcdBarrier b; b.bar = bar; b.x = xb_xcc_id(); b.st = st;
    if (threadIdx.x == 0) (void)xb_add(&bar[XB_XCNT(b.x)], 1u);
    return b;
}
__device__ __forceinline__ void xcd_barrier_complete(unsigned* bar, unsigned x, unsigned& nloc, unsigned& nx) {
    const unsigned G = gridDim.x * gridDim.y * gridDim.z;
    unsigned sum, cnt, mine, sp = 0u;
    for (;;) {
        sum = 0u; cnt = 0u; mine = 0u;
#pragma unroll
        for (unsigned j = 0; j < 16; ++j) { const unsigned c = xb_ld(&bar[XB_XCNT(j)]); sum += c; cnt += (c > 0u) ? 1u : 0u; mine = (j == x) ? c : mine; }
        if (sum == G) break;
        __builtin_amdgcn_s_sleep(1);
        if ((++sp & 255u) == 0u) { if (xb_ld(&bar[XB_TMO])) break; if (sp > XB_SPIN_CAP) { atomicAdd(&bar[XB_TMO], 1u); break; } }
    }
    nloc = mine > 0u ? mine : 1u; nx = cnt > 0u ? cnt : 1u;
}
__device__ __forceinline__ void xcd_barrier(const XcdBarrier& b) {
    asm volatile("s_waitcnt vmcnt(0)" ::: "memory");
    __syncthreads();
    if (threadIdx.x == 0) {
        unsigned* bar = b.bar;
        __builtin_amdgcn_s_waitcnt(0);
        unsigned nloc = b.st[0], nx = b.st[1];
        if (nloc == 0u) { xcd_barrier_complete(bar, b.x, nloc, nx); b.st[0] = nloc; b.st[1] = nx; }
        const unsigned old = xb_add(&bar[XB_XSUB(b.x)], 1u);
        const unsigned gen = old / nloc;
        if (old + 1u == (gen + 1u) * nloc) {
            __builtin_amdgcn_fence(__ATOMIC_RELEASE, "agent");
            asm volatile("s_waitcnt vmcnt(0)" ::: "memory");
            const unsigned og = xb_add(&bar[XB_TOP], 1u);
            const unsigned tg = og / nx;
            if (og + 1u == (tg + 1u) * nx) xb_add(&bar[XB_TOPGEN], 1u);
            else XB_SPIN(xb_ld(&bar[XB_TOPGEN]) == tg, bar);
            __builtin_amdgcn_fence(__ATOMIC_ACQUIRE, "agent");
            xb_add(&bar[XB_XGEN(b.x)], 1u);
            asm volatile("s_waitcnt vmcnt(0)" ::: "memory");
        } else {
            XB_SPIN(xb_ld(&bar[XB_XGEN(b.x)]) == gen, bar);
            __builtin_amdgcn_fence(__ATOMIC_ACQUIRE, "agent");
            asm volatile("s_waitcnt vmcnt(0)" ::: "memory");
        }
    }
    __syncthreads();
}

__device__ __forceinline__ float wave_sum(float v) {
#pragma unroll
    for (int o = 1; o < 64; o <<= 1) v += __shfl_xor(v, o);
    return v;
}

struct MapIn {
    static constexpr bool VEC2 = false;
    __device__ __forceinline__ static int src(int n) {
        if (n < 640) return n;
        if (n < 704) { const int j = n - 640; return 640 + ((j & 1) ? 32 + (j >> 1) : (j >> 1)); }
        if (n < 768) { const int j = n - 704; return 4288 + (j < 32 ? ((j & 1) ? 16 + (j >> 1) : (j >> 1)) : j); }
        if (n < 3840) { const int j = n - 768, part = j >> 10, hh = (j & 1023) >> 7, d = j & 127; const int base = 704 + part * 1024 + hh * 128;
            return base + (part < 2 ? ((d & 1) ? 64 + (d >> 1) : (d >> 1)) : d); }
        if (n < 4352) { const int j = n - 3840, hh = j >> 6, d = j & 63; return 3776 + hh * 64 + (d < 32 ? ((d & 1) ? 16 + (d >> 1) : (d >> 1)) : d); }
        return 4360 + (n - 4352);
    }
};
struct MapUq { static constexpr bool VEC2 = false; __device__ __forceinline__ static int src(int n) { const int hh = n / 192, d = n - hh * 192; if (d < 128) return n; const int j = d - 128; return hh * 192 + 128 + ((j & 1) ? 32 + (j >> 1) : (j >> 1)); } };
struct MapId { static constexpr bool VEC2 = true; __device__ __forceinline__ static int src(int n) { return n; } };
struct MapGu { static constexpr bool VEC2 = true; __device__ __forceinline__ static int src(int n) { const int pn = n >> 8, wth = n & 255; return wth < 128 ? 128 * pn + wth : 1024 + 128 * pn + (wth - 128); } };
template <class Map>
__device__ __forceinline__ void p0_transpose_item(const float* W, int K, int Nsrc, int nblk, bf16* WT, const float* kscale, LAS float* scr, int item, int lane, unsigned char* WT8 = nullptr, int K8 = 0) {
    const int kb = item / nblk, nb = item - kb * nblk, k0 = 64 * kb, n0 = 64 * nb;
    if constexpr (Map::VEC2) {
        const int sc = Map::src(n0 + 2 * (lane & 31)), hk = lane >> 5;
        typedef float f32x2_ __attribute__((ext_vector_type(2)));
        f32x2_ v[32];
#pragma unroll
        for (int i = 0; i < 32; ++i) v[i] = *(const GAS f32x2_*)(W + (size_t)(k0 + 2 * i + hk) * Nsrc + sc);
#pragma unroll
        for (int i = 0; i < 32; ++i) { const int kk = 2 * i + hk; float sc_ = kscale ? kscale[k0 + kk] : 1.f; scr[kk * 65 + 2 * (lane & 31)] = v[i].x * sc_; scr[kk * 65 + 2 * (lane & 31) + 1] = v[i].y * sc_; }
    } else {
    const int sc = Map::src(n0 + lane);
    float vv[64];
#pragma unroll
    for (int i = 0; i < 64; ++i) vv[i] = W[(size_t)(k0 + i) * Nsrc + sc];
#pragma unroll
    for (int i = 0; i < 64; ++i) { float v = vv[i]; if (kscale) v *= kscale[k0 + i]; scr[i * 65 + lane] = v; }
    }
    LDS_WAIT(); asm volatile("" ::: "memory");
    const int c = lane & 7;
#pragma unroll
    for (int j = 0; j < 8; ++j) { const int n = (lane >> 3) + 8 * j; const LAS float* s = scr + (8 * c) * 65 + n;
        if (WT) { v4u o; o.x = pk2(s[0 * 65], s[1 * 65]); o.y = pk2(s[2 * 65], s[3 * 65]); o.z = pk2(s[4 * 65], s[5 * 65]); o.w = pk2(s[6 * 65], s[7 * 65]);
            *(GAS v4u*)(WT + (size_t)(n0 + n) * K + k0 + 8 * c) = o; }
        if (WT8) { int w0 = 0, w1 = 0;
            w0 = __builtin_amdgcn_cvt_pk_fp8_f32(s[0 * 65] * 64.f, s[1 * 65] * 64.f, w0, false); w0 = __builtin_amdgcn_cvt_pk_fp8_f32(s[2 * 65] * 64.f, s[3 * 65] * 64.f, w0, true);
            w1 = __builtin_amdgcn_cvt_pk_fp8_f32(s[4 * 65] * 64.f, s[5 * 65] * 64.f, w1, false); w1 = __builtin_amdgcn_cvt_pk_fp8_f32(s[6 * 65] * 64.f, s[7 * 65] * 64.f, w1, true);
            v2u o8; o8.x = (unsigned)w0; o8.y = (unsigned)w1; *(GAS v2u*)(WT8 + (size_t)(n0 + n) * K8 + k0 + 8 * c) = o8; } }
    LDS_WAIT(); asm volatile("" ::: "memory");
}

#ifndef P1_BF16_TILES
#define P1_BF16_TILES ((1u << 2) | (1u << 15) | (1u << 16))
#endif
#ifndef PHASE_MASK
#define PHASE_MASK 0xFFFF
#endif
struct Args { const float* in[20]; float* out; unsigned char* ws; };

__global__ void __launch_bounds__(NWAVES * 64, 2) fwd_megakernel(Args args) {
    extern __shared__ __attribute__((aligned(16))) unsigned char lds[];
    LAS unsigned char* ldsl = (LAS unsigned char*)lds;
    volatile LAS unsigned* MISC = (volatile LAS unsigned*)(ldsl + MISC_OFF);
#define PHASE_IDS int tid_ = threadIdx.x; asm volatile("" : "+v"(tid_)); const int tid = tid_, lane = tid & 63, wave = __builtin_amdgcn_readfirstlane(tid >> 6); const int gw = vcu * NWAVES + wave, NGW = G * NWAVES; (void)lane; (void)gw; (void)NGW;
    const int G = gridDim.x, bx = blockIdx.x;
    const int vcu = (G % 8 == 0) ? (bx % 8) * (G / 8) + bx / 8 : bx;
    unsigned char* ws = args.ws;
    unsigned* ctl = (unsigned*)(ws + WS_CTL);
    const float* x = args.in[0]; const float* norm_attn_g = args.in[1]; const float* w_in = args.in[2]; const float* q_lora_g = args.in[3]; const float* kv_lora_g = args.in[4];
    const float* w_uq = args.in[5]; const float* w_uk = args.in[6]; const float* w_uv = args.in[7]; const float* w_o_mla = args.in[8]; const float* w_o_dsa = args.in[9];
    const float* b_gate = args.in[10]; const float* w_out = args.in[11]; const float* norm_ffn_g = args.in[12]; const float* w_router = args.in[13]; const float* b_router = args.in[14];
    const float* w_gate_up = args.in[15]; const float* b_gate_up = args.in[16]; const float* w_down = args.in[17]; const float* b_down = args.in[18]; const float* norm_final_g = args.in[19];
    float* out = args.out;
    float* widx = (float*)(ws + WS_WIDX); float* ssq = (float*)(ws + WS_SSQ); int* pick = (int*)(ws + WS_PICK); unsigned* mask = (unsigned*)(ws + WS_MASK);
    int* tokl = (int*)(ws + WS_TOK); float* gatek = (float*)(ws + WS_MASK);
    bf16* wrh = (bf16*)(ws + WS_WRH);
    bf16* win_t = (bf16*)(ws + WS_WIN); bf16* wuq_t = (bf16*)(ws + WS_WUQ); bf16* wuk_t = (bf16*)(ws + WS_WUK); bf16* wuv_t = (bf16*)(ws + WS_WUV);
    bf16* woa_t = (bf16*)(ws + WS_WOA); bf16* wob_t = (bf16*)(ws + WS_WOB); bf16* wout_t = (bf16*)(ws + WS_WOUT); bf16* wgu_t = (bf16*)(ws + WS_WGU); bf16* wdn_t = (bf16*)(ws + WS_WDN);
    bf16* hbuf = (bf16*)(ws + WS_RA); unsigned char* h8 = ws + WS_RA + 64 * MiB; unsigned char* win8 = ws + WS_WIN8;
    unsigned char* attn_out = ws + WS_RA; bf16* hn = (bf16*)(ws + WS_RA);
    unsigned char* woa8 = ws + WS_WOA8; unsigned char* wob8 = ws + WS_WOB8; unsigned char* wout8 = ws + WS_WOUT8; unsigned char* merged8 = ws + WS_RC + RC_MG;
    unsigned char* wuq8 = ws + WS_WUQ8; unsigned char* wuk8 = ws + WS_WUK8; unsigned char* wuv8 = ws + WS_WUV8; unsigned char* lat8 = ws + WS_RA + 96 * MiB;
    bf16* proj = (bf16*)(ws + WS_RB); bf16* act = (bf16*)(ws + WS_RB);
    bf16* mla_q = (bf16*)(ws + WS_RC + RC_Q); bf16* mla_k = (bf16*)(ws + WS_RC + RC_K); bf16* mla_v = (bf16*)(ws + WS_RC + RC_V);
    bf16* merged_a = (bf16*)(ws + WS_RC + RC_MA); bf16* merged = (bf16*)(ws + WS_RC + RC_MG); bf16* ybuf = (bf16*)(ws + WS_RC);
    unsigned* gcnt = ctl + CW_CNT;

    for (int u = threadIdx.x; u < (LDS_BYTES - LDSCTL_OFF) / 4; u += NWAVES * 64) ((LAS unsigned*)(ldsl + LDSCTL_OFF))[u] = 0u;
    __syncthreads();
    XcdBarrier bar = xcd_barrier_post(ctl + CW_BAR, MISC + 8);
#define GRID_BAR() xcd_barrier(bar)
    LAS int* cum = (LAS int*)(ldsl + TAB_OFF); LAS int* cntt = cum + 33; LAS int* offt = cntt + 32;

#if PHASE_MASK & (1 << 0)
    {
        PHASE_IDS
        LAS float* scr = (LAS float*)(ldsl + wave * 16640);
        constexpr int I_IN = 16 * 100, I_UQ = 6 * 24, I_UK = 4 * 16, I_UV = 4 * 16, I_O = 16 * 16, I_GU = 16 * 32, I_DN = 16 * 16;
        constexpr int NITEMS = I_IN + I_UQ + I_UK + I_UV + 3 * I_O;
        REPS(0) for (int it = gw; it < NITEMS; it += NGW) {
            int r = it;
            if (r < I_IN) { p0_transpose_item<MapIn>(w_in, 1024, 6408, 100, win_t, nullptr, scr, r, lane, win8, 1024); continue; } r -= I_IN;
            if (r < I_UQ) { p0_transpose_item<MapUq>(w_uq, 384, 1536, 24, nullptr, q_lora_g, scr, r, lane, wuq8, 512); continue; } r -= I_UQ;
            if (r < I_UK) { p0_transpose_item<MapId>(w_uk, 256, 1024, 16, nullptr, kv_lora_g, scr, r, lane, wuk8, 256); continue; } r -= I_UK;
            if (r < I_UV) { p0_transpose_item<MapId>(w_uv, 256, 1024, 16, nullptr, kv_lora_g, scr, r, lane, wuv8, 256); continue; } r -= I_UV;
            if (r < I_O) { p0_transpose_item<MapId>(w_o_mla, 1024, 1024, 16, nullptr, nullptr, scr, r, lane, woa8, 1024); continue; } r -= I_O;
            if (r < I_O) { p0_transpose_item<MapId>(w_o_dsa, 1024, 1024, 16, nullptr, nullptr, scr, r, lane, wob8, 1024); continue; } r -= I_O;
            p0_transpose_item<MapId>(w_out, 1024, 1024, 16, nullptr, nullptr, scr, r, lane, wout8, 1024);
        }
        __syncthreads();
        for (int idx = (int)blockIdx.x * (NWAVES * 64) + tid; idx < 1536 * 8; idx += G * NWAVES * 64) *(GAS v4u*)(wuq8 + (size_t)(idx >> 3) * 512 + 384 + 16 * (idx & 7)) = (v4u){0u, 0u, 0u, 0u};
        for (int idx = (int)blockIdx.x * (NWAVES * 64) + tid; idx < 32 * 1024; idx += G * NWAVES * 64) { const int e = idx >> 10, k = idx & 1023;
            const float xw = w_router[(size_t)k * 32 + e]; const unsigned hb = f2bf(xw); const float lw = xw - __uint_as_float(hb << 16);
            wrh[idx] = (bf16)hb; wrh[32 * 1024 + idx] = (bf16)f2bf(lw); }
        LAS float* wx = (LAS float*)ldsl;
        for (int i = tid; i < 8 * 1024; i += NWAVES * 64) { const int k = i >> 3, hh = i & 7; wx[hh * 1024 + k] = w_in[(size_t)k * 6408 + 4352 + hh]; }
        __syncthreads();
        REPS(10) for (int m = gw; m < T; m += NGW) {
            const GAS f32x4* xr = (const GAS f32x4*)(x + (size_t)m * DM) + lane;
            f32x4 v[4]; float s = 0.f;
#pragma unroll
            for (int j = 0; j < 4; ++j) { v[j] = xr[64 * j]; s += (v[j].x * v[j].x + v[j].y * v[j].y) + (v[j].z * v[j].z + v[j].w * v[j].w); }
            const float rstd = __builtin_amdgcn_rsqf(wave_sum(s) * (1.f / DM) + 1e-6f);
            GAS v2u* o8 = (GAS v2u*)(hbuf + (size_t)m * DM) + lane; GAS unsigned* o4 = (GAS unsigned*)(h8 + (size_t)m * DM) + lane;
#pragma unroll
            for (int j = 0; j < 4; ++j) { const f32x4 gg = *((const GAS f32x4*)norm_attn_g + lane + 64 * j); v[j] = v[j] * rstd * gg;
                v2u o; o.x = pk2(v[j].x, v[j].y); o.y = pk2(v[j].z, v[j].w); o8[64 * j] = o;
                int w8 = 0; w8 = __builtin_amdgcn_cvt_pk_fp8_f32(v[j].x * 16.f, v[j].y * 16.f, w8, false); w8 = __builtin_amdgcn_cvt_pk_fp8_f32(v[j].z * 16.f, v[j].w * 16.f, w8, true); o4[64 * j] = (unsigned)w8; }
            float mine = 0.f;
#pragma unroll
            for (int hh = 0; hh < 8; ++hh) { float d = 0.f;
#pragma unroll
                for (int j = 0; j < 4; ++j) { const f32x4 wv = *((const LAS f32x4*)(wx + hh * 1024) + lane + 64 * j); d += (v[j].x * wv.x + v[j].y * wv.y) + (v[j].z * wv.z + v[j].w * wv.w); }
                d = wave_sum(d); if (lane == hh) mine = d; }
            if (lane < 8) widx[(size_t)m * 8 + lane] = mine * 0.35355339059327373f;
        }
        __syncthreads();
    }
    GRID_BAR();

#endif
#if PHASE_MASK & (1 << 1)
#ifdef PROBE_XBAR
    for (int xb_ = 0; xb_ < PROBE_XBAR; ++xb_) GRID_BAR();
#endif
    REPS(1) {
        constexpr unsigned P1_BF16 = P1_BF16_TILES, P1_ALL = (1u << 25) - 1u;
        pg8::EpiProj E{proj, b_gate, ssq, lat8};
        if (P1_BF16) { pg8::DenseOrder S; S.init(hbuf, 1024, win_t, 1024, T, 6400, G, bx, 2, P1_BF16);
          pg8::gemm_phase<pg8::EpiProj, pg8::DenseOrder, false>(ldsl, 1024, 1024, S, E, rep_ > 0); }
        { pg8::DenseOrder S; S.init(h8, 1024, win8, 1024, T, 6400, G, bx, 1, P1_ALL & ~P1_BF16, true);
          pg8::gemm_phase<pg8::EpiProj, pg8::DenseOrder, true, true>(ldsl, 1024, 1024, S, E, rep_ > 0, 0x79797979, 0x7b7b7b7b); }
    }
    GRID_BAR();

#endif
#if PHASE_MASK & (1 << 2)
    {
        REPS(2) {
        { pg8::DenseOrder S; S.init(lat8, 640, wuq8, 512, T, 1536, G, bx, 1, 0u, true); pg8::EpiMla E{mla_q, 1536, ssq, 0, 12, 1.f / 384.f, 1};
          pg8::gemm_phase<pg8::EpiMla, pg8::DenseOrder, true, true>(ldsl, 512, 640, S, E, false, 0x79797979, 0x7b7b7b7b); }
        { pg8::DenseOrder S; S.init(lat8 + 384, 640, wuk8, 256, T, 1024, G, bx, 1, 0u, true); pg8::EpiMla E{mla_k, 1024, ssq, 12, 8, 1.f / 256.f, 0};
          pg8::gemm_phase<pg8::EpiMla, pg8::DenseOrder, true, true>(ldsl, 256, 640, S, E, false, 0x79797979, 0x7b7b7b7b); }
        { pg8::DenseOrder S; S.init(lat8 + 384, 640, wuv8, 256, T, 1024, G, bx, 1, 0u, true); pg8::EpiMla E{mla_v, 1024, ssq, 12, 8, 1.f / 256.f, 0};
          pg8::gemm_phase<pg8::EpiMla, pg8::DenseOrder, true, true>(ldsl, 256, 640, S, E, false, 0x79797979, 0x7b7b7b7b); }
        __syncthreads(); }
        REPS(12) {
            const idx::Conv cv{w_gate_up, w_down, wgu_t, wdn_t};
            int tdone = 0;
            for (int i = 0; ; ++i) { const int u = i * G + bx; if (u >= 2048) break;
                const int b = u >> 7, qraw = u & 127, qg = (i & 1) ? 127 - qraw : qraw;
                const int quota = (G == 256) ? min(12, 96 - tdone) : 0;
                idx::index_unit(proj, widx, mask, b, qg, ldsl, cv, vcu * 96 + tdone, quota); tdone += quota; }
            { const int w8 = __builtin_amdgcn_readfirstlane((int)threadIdx.x >> 6);
              if (G == 256) { for (int t = tdone + w8; t < 96; t += NWAVES) idx::conv_super(cv, vcu * 96 + t, (int)threadIdx.x & 63); }
              else { for (int st = vcu * NWAVES + w8; st < 24576; st += G * NWAVES) idx::conv_super(cv, st, (int)threadIdx.x & 63); } }
        }
    }
    GRID_BAR();

#endif
#if PHASE_MASK & (1 << 3)
    {
        for (int pass = 0; pass < 2; ++pass) REPS(3 + 10 * pass)
            for (int r = 0; ; ++r) {
                const int slot = r * G + ((r & 1) ? (G - 1 - bx) : bx); if (slot >= 1024) break;
                const int qb = 7 - (slot >> 7), bh = slot & 127, b = bh >> 3, h = bh & 7, i0 = qb * 256;
                const size_t row0 = (size_t)b * SEQ;
                if (pass == 0) REPS(33) {
#if !defined(ATT_ONLY) || ATT_ONLY == 0
                    att::attn_unit<0, 1536, 1024>(mla_q + (row0 + i0) * 1536 + h * 192, mla_k + row0 * 1024 + h * 128, mla_v + row0 * 1024 + h * 128, proj + row0 * PP + 640, nullptr,
                                                  attn_out + (row0 + i0) * 2048 + h * 128, i0, (char*)lds);
#endif
                } else REPS(34) {
#if !defined(ATT_ONLY) || ATT_ONLY == 1
                    att::attn_unit<1, PP, PP>(proj + (row0 + i0) * PP + 768 + h * 128, proj + row0 * PP + 1792 + h * 128, proj + row0 * PP + 2816 + h * 128, nullptr, mask + (row0 + i0) * 64,
                                              attn_out + (row0 + i0) * 2048 + 1024 + h * 128, i0, (char*)lds);
#endif
                }
            }
    }
    GRID_BAR();

#endif
#if PHASE_MASK & (1 << 4)
    REPS(4) {
        { pg8::DenseOrder S; S.init(attn_out, 2048, woa8, 1024, T, 1024, G, bx, 1, 0u, true); pg8::EpiGate E{merged_a, nullptr, proj + 4352, nullptr};
          pg8::gemm_phase<pg8::EpiGate, pg8::DenseOrder, true, true>(ldsl, 1024, 2048, S, E, false, 0x79797979, 0x7a7a7a7a); }
        VM_WAIT(); __syncthreads();
        { pg8::DenseOrder S; S.init(attn_out + 1024, 2048, wob8, 1024, T, 1024, G, bx, 1, 0u, true); pg8::EpiGate E{nullptr, merged_a, proj + 5376, merged8};
          pg8::gemm_phase<pg8::EpiGate, pg8::DenseOrder, true, true>(ldsl, 1024, 2048, S, E, false, 0x79797979, 0x7a7a7a7a); }
    }
    GRID_BAR();

#endif
#if PHASE_MASK & (1 << 5)
    REPS(5) {
        pg8::DenseOrder S; S.init(merged8, 1024, wout8, 1024, T, 1024, G, bx, 1, 0u, true); pg8::EpiX1 E{x, out, ssq};
        pg8::gemm_phase<pg8::EpiX1, pg8::DenseOrder, true, true>(ldsl, 1024, 1024, S, E, false, 0x79797979, 0x79797979);
    }
    GRID_BAR();

#endif
#if PHASE_MASK & (1 << 6)
    {
        PHASE_IDS
        LAS unsigned* cntl = (LAS unsigned*)(ldsl + 120 * 1024); LAS unsigned* basel = cntl + 32;
        LAS unsigned char* hnl = ldsl + wave * (2 * 16 * 272); LAS float* lgl = (LAS float*)(ldsl + 80 * 1024 + wave * (16 * 32 * 4));
        typedef short bf16x8_ __attribute__((ext_vector_type(8)));
        const int q = lane & 15, g = lane >> 4;
        REPS(6) for (int grp = bx; grp < T / 128; grp += G) {
            const bool fx_ = (REPEAT_PHASE != 6) || rep_ == 1;
            if (tid < 32) cntl[tid] = 0u;
            __syncthreads();
            const int t0 = grp * 128 + wave * 16;
            float myr = 0.f;
            if (lane < 16) { const GAS f32x4* sp = (const GAS f32x4*)(ssq + (size_t)(t0 + lane) * 16); const f32x4 a = sp[0], b = sp[1], c = sp[2], d = sp[3];
                const float tot = (((a[0] + a[1]) + (a[2] + a[3])) + ((b[0] + b[1]) + (b[2] + b[3]))) + (((c[0] + c[1]) + (c[2] + c[3])) + ((d[0] + d[1]) + (d[2] + d[3])));
                myr = __builtin_amdgcn_rsqf(tot * (1.f / DM) + 1e-6f); }
            f32x4 acc0, acc1;
            REPS(62) {
            acc0 = (f32x4){0.f, 0.f, 0.f, 0.f}; acc1 = (f32x4){0.f, 0.f, 0.f, 0.f};
            const bf16* wq = wrh + (size_t)q * 1024 + 8 * g;
            f32x4 xv[8];
#pragma unroll
            for (int ii = 0; ii < 8; ++ii) xv[ii] = *(const GAS f32x4*)(out + (size_t)(t0 + 2 * ii + (lane >> 5)) * DM + 4 * (lane & 31));
#pragma unroll 1
            for (int kc = 0; kc < 8; ++kc) {
                const int col = 128 * kc + 4 * (lane & 31);
                const f32x4 gg = *(const GAS f32x4*)(norm_ffn_g + col);
                bf16x8_ bh0[4], bl0[4], bh1[4], bl1[4];
#pragma unroll
                for (int s = 0; s < 4; ++s) { const bf16* p = wq + 128 * kc + 32 * s;
                    bh0[s] = *(const bf16x8_*)p; bh1[s] = *(const bf16x8_*)(p + 16 * 1024); bl0[s] = *(const bf16x8_*)(p + 32 * 1024); bl1[s] = *(const bf16x8_*)(p + 48 * 1024); }
#pragma unroll
                for (int ii = 0; ii < 8; ++ii) { const int i = 2 * ii + (lane >> 5); const float r = __shfl(myr, i);
                    f32x4 v = xv[ii] * r * gg;
                    const unsigned h0 = f2bf(v.x), h1 = f2bf(v.y), h2 = f2bf(v.z), h3 = f2bf(v.w);
                    v2u o; o.x = h0 | (h1 << 16); o.y = h2 | (h3 << 16);
                    { int w8 = 0; w8 = __builtin_amdgcn_cvt_pk_fp8_f32(v.x * 4.f, v.y * 4.f, w8, false); w8 = __builtin_amdgcn_cvt_pk_fp8_f32(v.z * 4.f, v.w * 4.f, w8, true);
                      *(GAS int*)((GAS unsigned char*)hn + (size_t)(t0 + i) * DM + col) = w8; }
                    v2u l; l.x = pk2(v.x - __uint_as_float(h0 << 16), v.y - __uint_as_float(h1 << 16)); l.y = pk2(v.z - __uint_as_float(h2 << 16), v.w - __uint_as_float(h3 << 16));
                    *(LAS v2u*)(hnl + i * 272 + 8 * (lane & 31)) = o; *(LAS v2u*)(hnl + 16 * 272 + i * 272 + 8 * (lane & 31)) = l; }
                if (kc < 7) {
#pragma unroll
                    for (int ii = 0; ii < 8; ++ii) xv[ii] = *(const GAS f32x4*)(out + (size_t)(t0 + 2 * ii + (lane >> 5)) * DM + col + 128);
                }
                LDS_WAIT(); asm volatile("" ::: "memory");
#pragma unroll
                for (int s = 0; s < 4; ++s) {
                    const bf16x8_ ah = *(const LAS bf16x8_*)(hnl + q * 272 + (32 * s + 8 * g) * 2), al = *(const LAS bf16x8_*)(hnl + 16 * 272 + q * 272 + (32 * s + 8 * g) * 2);
                    acc0 = __builtin_amdgcn_mfma_f32_16x16x32_bf16(ah, bh0[s], acc0, 0, 0, 0); acc1 = __builtin_amdgcn_mfma_f32_16x16x32_bf16(ah, bh1[s], acc1, 0, 0, 0);
                    acc0 = __builtin_amdgcn_mfma_f32_16x16x32_bf16(ah, bl0[s], acc0, 0, 0, 0); acc1 = __builtin_amdgcn_mfma_f32_16x16x32_bf16(ah, bl1[s], acc1, 0, 0, 0);
                    acc0 = __builtin_amdgcn_mfma_f32_16x16x32_bf16(al, bh0[s], acc0, 0, 0, 0); acc1 = __builtin_amdgcn_mfma_f32_16x16x32_bf16(al, bh1[s], acc1, 0, 0, 0);
                }
                LDS_WAIT(); asm volatile("" ::: "memory");
            }
            }
            { const float b0 = b_router[q], b1 = b_router[16 + q];
#pragma unroll
              for (int r = 0; r < 4; ++r) { lgl[(4 * g + r) * 32 + q] = acc0[r] + b0; lgl[(4 * g + r) * 32 + 16 + q] = acc1[r] + b1; } }
            LDS_WAIT(); asm volatile("" ::: "memory");
            int pe[4] = {0, 0, 0, 0}; float pg[4] = {0.f, 0.f, 0.f, 0.f}; unsigned prl[4] = {0u, 0u, 0u, 0u};
            if (lane < 16) {
                float lv[32];
#pragma unroll
                for (int e = 0; e < 32; ++e) lv[e] = lgl[lane * 32 + e];
                unsigned used = 0u; float tv[4];
#pragma unroll
                for (int k = 0; k < 4; ++k) { float best = -INFINITY; int bi = 0;
#pragma unroll
                    for (int e = 0; e < 32; ++e) { const bool ok = !((used >> e) & 1u) && lv[e] > best; best = ok ? lv[e] : best; bi = ok ? e : bi; }
                    used |= 1u << bi; pe[k] = bi; tv[k] = best; }
                const float e1 = __expf(tv[1] - tv[0]), e2 = __expf(tv[2] - tv[0]), e3 = __expf(tv[3] - tv[0]); const float inv = 1.f / (1.f + e1 + e2 + e3);
                pg[0] = inv; pg[1] = e1 * inv; pg[2] = e2 * inv; pg[3] = e3 * inv;
#pragma unroll
                for (int k = 0; k < 4; ++k) prl[k] = __hip_atomic_fetch_add(&cntl[pe[k]], 1u, __ATOMIC_RELAXED, __HIP_MEMORY_SCOPE_WORKGROUP);
            }
            __syncthreads();
            if (tid < 32 && fx_) basel[tid] = __hip_atomic_fetch_add(&gcnt[tid], cntl[tid], __ATOMIC_RELAXED, __HIP_MEMORY_SCOPE_AGENT);
            __syncthreads();
            if (lane < 16 && fx_) {
                const int tok = t0 + lane;
#pragma unroll
                for (int k = 0; k < 4; ++k) { const int e = pe[k]; const unsigned rank = basel[e] + prl[k];
                    tokl[(size_t)e * 32768 + rank] = tok; gatek[tok * 4 + k] = pg[k]; pick[tok * 4 + k] = (int)((rank << 5) | (unsigned)e); }
            }
            __syncthreads();
        }
    }
    GRID_BAR();

#endif
#if PHASE_MASK & (1 << 7)
    if (threadIdx.x == 0) { int c = 0, o = 0;
        for (int e = 0; e < 32; ++e) { const int n = (int)__hip_atomic_load(&gcnt[e], __ATOMIC_RELAXED, __HIP_MEMORY_SCOPE_AGENT); cum[e] = c; cntt[e] = n; offt[e] = o; c += (n + 255) >> 8; o += n; }
        cum[32] = c; offt[32] = o; }
    __syncthreads();
    REPS_RT(7) {
        pg8::MoeOrder S{cum, cntt, offt, 8, G, bx, 1024, (const char*)hn, (const char*)wgu_t, (size_t)2048 * 1024, tokl, true, 1};
        pg8::EpiAct E{act, b_gate_up};
        pg8::gemm_phase<pg8::EpiAct, pg8::MoeOrder, true, true>(ldsl, 1024, 1024, S, E, rep_ > 0);
    }
    GRID_BAR();
#endif
#if PHASE_MASK & (1 << 8)
    REPS_RT(8) {
        pg8::MoeOrder S{cum, cntt, offt, 4, G, bx, 1024, (const char*)act, (const char*)wdn_t, (size_t)1024 * 1024, nullptr, false, 1};
        pg8::EpiY E{ybuf, b_down};
        pg8::gemm_phase<pg8::EpiY, pg8::MoeOrder, true, true>(ldsl, 1024, 1024, S, E, rep_ > 0);
    }
    GRID_BAR();

#endif
#if PHASE_MASK & (1 << 9)
    {
        PHASE_IDS
        for (int m = gw; m < T; m += NGW) {
            GAS f32x4* xr = (GAS f32x4*)(out + (size_t)m * DM) + lane;
            f32x4 v[4];
#pragma unroll
            for (int j = 0; j < 4; ++j) v[j] = xr[64 * j];
#pragma unroll
            for (int k = 0; k < 4; ++k) { const int p = __builtin_amdgcn_readfirstlane(pick[m * 4 + k]); const int e = p & 31, rank = (int)((unsigned)p >> 5);
                const float gk = 0.0625f * __uint_as_float((unsigned)__builtin_amdgcn_readfirstlane((int)__float_as_uint(gatek[m * 4 + k])));
                const GAS unsigned* yr = (const GAS unsigned*)((const GAS unsigned char*)ybuf + (size_t)(offt[e] + rank) * DM) + lane;
#pragma unroll
                for (int j = 0; j < 4; ++j) { const int w = (int)yr[64 * j]; typedef float f32x2_ __attribute__((ext_vector_type(2))); const f32x2_ lo = __builtin_amdgcn_cvt_pk_f32_fp8(w, false), hi = __builtin_amdgcn_cvt_pk_f32_fp8(w, true);
                    v[j].x = fmaf(gk, lo.x, v[j].x); v[j].y = fmaf(gk, lo.y, v[j].y); v[j].z = fmaf(gk, hi.x, v[j].z); v[j].w = fmaf(gk, hi.y, v[j].w); } }
            float s = 0.f;
#pragma unroll
            for (int j = 0; j < 4; ++j) s += (v[j].x * v[j].x + v[j].y * v[j].y) + (v[j].z * v[j].z + v[j].w * v[j].w);
            const float rstd = __builtin_amdgcn_rsqf(wave_sum(s) * (1.f / DM) + 1e-6f);
#pragma unroll
            for (int j = 0; j < 4; ++j) { const f32x4 gg = *((const GAS f32x4*)norm_final_g + lane + 64 * j); xr[64 * j] = v[j] * rstd * gg; }
        }
    }
#endif
}

extern "C" void kernel_launch(void* const* d_in, const int* in_sizes, int n_in, void* d_out, int out_size, void* d_ws, size_t ws_size, hipStream_t stream) {
    static int grid = 0;
    if (grid == 0) {
        if (n_in != 20 || in_sizes[0] != T * DM || out_size != T * DM || ws_size < WS_END) { fprintf(stderr, "kernel_launch: unexpected shapes (n_in %d, in0 %d, out %d, ws %zu < %zu); nothing launched\n", n_in, n_in > 0 ? in_sizes[0] : -1, out_size, ws_size, (size_t)WS_END); grid = -1; return; }
        int dev = 0, cus = 0, per_cu = 0;
        if (hipGetDevice(&dev) != hipSuccess || hipDeviceGetAttribute(&cus, hipDeviceAttributeMultiprocessorCount, dev) != hipSuccess) { grid = -1; return; }
        if (hipFuncSetAttribute((const void*)fwd_megakernel, hipFuncAttributeMaxDynamicSharedMemorySize, LDS_BYTES) != hipSuccess) { fprintf(stderr, "kernel_launch: hipFuncSetAttribute failed\n"); grid = -1; return; }
        if (hipOccupancyMaxActiveBlocksPerMultiprocessor(&per_cu, (const void*)fwd_megakernel, NWAVES * 64, LDS_BYTES) != hipSuccess || per_cu < 1) { fprintf(stderr, "kernel_launch: occupancy query says %d\n", per_cu); }
        (void)hipGetLastError();
        grid = cus;
    }
    if (grid < 0) return;
    (void)hipMemsetAsync((char*)d_ws + WS_CTL, 0, CTL_ZERO_BYTES, stream);
    Args a{};
    for (int i = 0; i < 20; ++i) a.in[i] = (const float*)d_in[i];
    a.out = (float*)d_out; a.ws = (unsigned char*)d_ws;
    hipLaunchKernelGGL(fwd_megakernel, dim3(grid), dim3(NWAVES * 64), LDS_BYTES, stream, a);
}
```

```cpp
#include <hip/hip_runtime.h>
#include <cstdio>
#include <cstdint>
#include <cmath>
#ifndef REPEAT_PHASE
#define REPEAT_PHASE -1
#endif
#define REPS(k) for (int rep_ = 0; rep_ < ((REPEAT_PHASE == (k)) ? 2 : 1); ++rep_)
__device__ __forceinline__ int opaque_n(int n) { asm volatile("" : "+s"(n)); return n; }
#define REPS_RT(k) for (int rep_ = 0, nrep_ = (REPEAT_PHASE == (k)) ? opaque_n(2) : 1; rep_ < nrep_; ++rep_)
namespace pg8 {
#define PG8_LAS __attribute__((address_space(3)))
typedef unsigned short bf16_t;
typedef short bf16x8 __attribute__((ext_vector_type(8)));
typedef float f32x4 __attribute__((ext_vector_type(4)));
typedef float f32x2 __attribute__((ext_vector_type(2)));
typedef unsigned u32x4 __attribute__((ext_vector_type(4)));
typedef unsigned u32x2 __attribute__((ext_vector_type(2)));
constexpr int PG8_TOKL_OFF = 139264 + 2048;
constexpr int BM = 256, BK = 64, HALF = 128, HTB = HALF * BK * 2  , STAGE_BYTES = 8 * HTB, NXCD = 8, WGM = 8;

__host__ __device__ __forceinline__ int lds_byte(int r, int c) { const int st = (r >> 4) * 2 + (c >> 5), rr = r & 15, cc = c & 31, ob = rr * 64 + cc * 2; return st * 1024 + (ob ^ (((ob >> 9) & 1) << 5)); }
__host__ __device__ __forceinline__ void stage_rc(int b, int& R, int& C) { const int st = b / 1024, sb = b % 1024, swz = sb ^ (((sb >> 9) & 1) << 5); R = (st >> 1) * 16 + swz / 64; C = (st & 1) * 32 + (swz % 64) / 2; }
__host__ __device__ __forceinline__ int perm32(int rho) { const int n = rho >> 4, i = rho & 15; return 8 * (i >> 2) + 4 * n + (i & 3); }

struct Unit { int pm, pn, e, rows, row_off; const char* A; const char* B; const int* toks; const char* A2; const char* B2; };

__device__ __forceinline__ int sdiv(int a, int b) { return (int)(((float)a + 0.5f) * __builtin_amdgcn_rcpf((float)b)); }
struct TileOrder {
    int nM, nN, nwg, G, c;
    __device__ void init(int nM_, int nN_, int G_, int c_) { nM = nM_; nN = nN_; nwg = nM * nN; G = G_; c = c_; }
    __device__ bool tile(int i, int& pm, int& pn) const {
        const long L = (long)i * G + c; if (L >= nwg) return false;
        int wgid = (int)L; { const int q = nwg / NXCD, r = nwg % NXCD, xcd = wgid % NXCD, off = wgid / NXCD; wgid = (xcd < r ? xcd * (q + 1) : r * (q + 1) + (xcd - r) * q) + off; }
        const int nig = WGM * nN, gid = sdiv(wgid, nig), fm = gid * WGM, gsz = (nM - fm) < WGM ? (nM - fm) : WGM, rem = wgid - gid * nig;
        if (gsz == WGM) { pm = fm + (rem & (WGM - 1)); pn = rem / WGM; } else { pn = sdiv(rem, gsz); pm = fm + (rem - pn * gsz); }
        return true;
    }
};
struct DenseOrder {
    TileOrder t; const char* A; const char* B; const char* A2 = nullptr; const char* B2 = nullptr; int lda, K, esz; unsigned sel; bool lin;
    __device__ void init(const void* A_, int lda_, const void* B_, int K_, int M, int N, int G, int c, int esz_ = 2, unsigned sel_ = 0u, bool lin_ = false) { lin = lin_;
        t.init(M / BM, sel_ ? __builtin_popcount(sel_) : N / BM, G, c); A = (const char*)A_; B = (const char*)B_; lda = lda_; K = K_; esz = esz_; sel = sel_; }
    __device__ bool next(int i, Unit& u) const {
        int pm, pn; if (!t.tile(i, pm, pn)) return false;
        if (sel) { int left = pn, p = 0;
#pragma unroll 1
            for (int k = 0; k < 32; ++k) { if ((sel >> k) & 1u) { if (left == 0) p = k; --left; } }
            pn = p; }
        u.pm = pm; u.pn = pn; u.e = 0; u.rows = BM; u.row_off = pm * BM; u.A = lin ? A : A + (size_t)pm * BM * lda * esz; u.B = B + (size_t)pn * BM * K * esz; u.toks = nullptr;
        u.A2 = A2; u.B2 = B2 ? B2 + (size_t)pn * BM * K * esz : nullptr; return true;
    }
};
struct MoeOrder {
    const PG8_LAS int* cum; const PG8_LAS int* cnt; const PG8_LAS int* off; int nN, G, c, K; const char* A; const char* B; size_t bstride; const int* toks; bool gather; int esz;
    __device__ bool next(int i, Unit& u) const {
        const int L0 = i * G + c; const int total = cum[32] * nN; if (L0 >= total) return false;
        int L = L0;
        if ((G & 7) == 0) { const int q = total >> 3, r = total & 7, xcd = L0 & 7, o = L0 >> 3; L = (xcd < r ? xcd * (q + 1) : r * (q + 1) + (xcd - r) * q) + o; }
        const int lk = (int)(threadIdx.x & 31u);
        const int e = __builtin_amdgcn_readfirstlane(__popcll(__ballot(L >= cum[lk + 1] * nN) & 0xffffffffull));
        const int te = cum[e + 1] - cum[e], r = L - cum[e] * nN, MB = 32 / nN;
        const int blk = r / (MB * nN), rr = r - blk * (MB * nN), rows = min(MB, te - blk * MB), pn = sdiv(rr, rows), mt = blk * MB + (rr - pn * rows);
        u.pm = mt; u.pn = pn; u.e = e; u.rows = min(BM, cnt[e] - mt * BM); u.row_off = off[e] + mt * BM;
        u.B = B + (size_t)e * bstride + (size_t)pn * BM * K * esz;
        if (gather) { u.A = A; u.toks = toks + (size_t)e * 32768 + mt * BM; } else { u.A = A; u.toks = nullptr; }
        return true;
    }
};

__device__ __forceinline__ unsigned cvt_pk_bf16(float lo, float hi) { unsigned r; asm volatile("v_cvt_pk_bf16_f32 %0, %1, %2" : "=v"(r) : "v"(lo), "v"(hi)); return r; }

typedef int v8i32 __attribute__((ext_vector_type(8)));
typedef int v4i32 __attribute__((ext_vector_type(4)));
template <class Epi, class Sched, bool GATHER, bool F8 = false, bool DUAL = false>
__device__ __forceinline__ void gemm_phase(PG8_LAS unsigned char* lds, const int K, const int lda, const Sched& S, const Epi& E, const bool noepi = false, const int SCL_B = 0x79797979  , const int SCL_A = 0x7d7d7d7d  ) {
    int tid_ = threadIdx.x; asm volatile("" : "+v"(tid_));
    const int tid = tid_, wid = __builtin_amdgcn_readfirstlane(tid >> 6), lane = tid & 63, wr = wid >> 2, wc = wid & 3, fr = lane & 15, fq = lane >> 4;
    constexpr int ESZ = F8 ? 1 : 2;
    int nt_ = (K * ESZ) / 128; asm volatile("" : "+s"(nt_)); const int nt = nt_;
    unsigned voffA[2], voffB[2];
#pragma unroll
    for (int i = 0; i < 2; ++i) { int R, C; stage_rc(tid * 16 + i * 8192, R, C); const int Rb = Epi::PERM ? ((R & ~31) + perm32(R & 31)) : R;
        voffA[i] = (unsigned)(R * lda * ESZ + C * 2); voffB[i] = (unsigned)(Rb * K * ESZ + C * 2); }
    const size_t kstep = (size_t)(BK * 2);
    const size_t hstepA = GATHER ? 0 : (size_t)HALF * lda * ESZ, hstepB = (size_t)HALF * K * ESZ;
    const unsigned ldsw = (unsigned)wid * 1024u;
    const int aoff = lds_byte(wr * 64 + fr, F8 ? fq * 16 : fq * 8), boff = lds_byte(wc * 32 + fr, F8 ? fq * 16 : fq * 8);
    constexpr int aoff1 = F8 ? 16 : 1024, boff1 = F8 ? 16 : 1024;
    unsigned vgC[2][2];
    const PG8_LAS int* tokl = (const PG8_LAS int*)(lds + PG8_TOKL_OFF);
#define PG8_SA(b, h) (((b) * 2 + (h)) * HTB)
#define PG8_SB(b, h) ((4 + (b) * 2 + (h)) * HTB)
#define PG8_STAGE(bufoff, gbase, voff) do { _Pragma("unroll") for (int _i = 0; _i < 2; ++_i) \
        __builtin_amdgcn_global_load_lds((const unsigned*)((const char*)(gbase) + (voff)[_i]), (PG8_LAS unsigned*)(lds + (bufoff) + ldsw + _i * 8192), 16, 0, 0); } while (0)
#define PG8_STAGEA(bufoff, gbase, h) do { if constexpr (GATHER) { PG8_STAGE(bufoff, gbase, vgC[h]); } else { PG8_STAGE(bufoff, (gbase) + (h) * hstepA, voffA); } } while (0)
#define PG8_GOFF(dst, u) do { _Pragma("unroll") for (int _h = 0; _h < 2; ++_h) _Pragma("unroll") for (int _i = 0; _i < 2; ++_i) { int _R, _C; stage_rc(tid * 16 + _i * 8192, _R, _C); const int _r = _h * HALF + _R; \
        const int _t = (u).toks ? (u).toks[min(_r, (u).rows - 1)] : (u).row_off + _r; dst[_h][_i] = (unsigned)(_t * lda * ESZ + _C * 2); } } while (0)
#define PG8_LD8(base) (__builtin_shufflevector(*(const PG8_LAS v4i32*)(base), *(const PG8_LAS v4i32*)((base) + aoff1_or_boff1), 0, 1, 2, 3, 4, 5, 6, 7))
#define PG8_LDA(dst, b, h) do { if constexpr (F8) { _Pragma("unroll") for (int m = 0; m < 4; ++m) { const int aoff1_or_boff1 = aoff1; dst##8[m] = PG8_LD8(lds + PG8_SA(b, h) + aoff + m * 2048); } } \
        else { _Pragma("unroll") for (int m = 0; m < 4; ++m) _Pragma("unroll") for (int k = 0; k < 2; ++k) dst[m][k] = *(const PG8_LAS bf16x8*)(lds + PG8_SA(b, h) + aoff + m * 2048 + k * 1024); } } while (0)
#define PG8_LDB(dst, b, h) do { if constexpr (F8) { _Pragma("unroll") for (int n = 0; n < 2; ++n) { const int aoff1_or_boff1 = boff1; dst##8[n] = PG8_LD8(lds + PG8_SB(b, h) + boff + n * 2048); } } \
        else { _Pragma("unroll") for (int n = 0; n < 2; ++n) _Pragma("unroll") for (int k = 0; k < 2; ++k) dst[n][k] = *(const PG8_LAS bf16x8*)(lds + PG8_SB(b, h) + boff + n * 2048 + k * 1024); } } while (0)
#define PG8_MMA(ai, bj, At, Bt) do { __builtin_amdgcn_s_setprio(1); _Pragma("unroll") for (int m = 0; m < 4; ++m) _Pragma("unroll") for (int n = 0; n < 2; ++n) { if constexpr (F8) { \
        acc[ai][bj][m][n] = __builtin_amdgcn_mfma_scale_f32_16x16x128_f8f6f4(Bt##8[n], At##8[m], acc[ai][bj][m][n], 0, 0, 0, SCL_B, 0, SCL_A); } else { _Pragma("unroll") for (int k = 0; k < 2; ++k) \
        acc[ai][bj][m][n] = __builtin_amdgcn_mfma_f32_16x16x32_bf16(Bt[n][k], At[m][k], acc[ai][bj][m][n], 0, 0, 0); } } __builtin_amdgcn_s_setprio(0); } while (0)
#define PG8_WAIT_V(n) asm volatile("s_waitcnt vmcnt(" #n ")" ::: "memory")
#define PG8_WAIT_L(n) asm volatile("s_waitcnt lgkmcnt(" #n ")" ::: "memory")
#define PG8_BAR __builtin_amdgcn_s_barrier()
#define PG8_SCHED __builtin_amdgcn_sched_barrier(0)
    Unit cur, nxt; int ui = 0;
    if (!S.next(0, cur)) return;
#ifdef STAGGER
    { const int dl = ((int)blockIdx.x >> 3) & 3; for (int k = 0; k < dl * STAGGER; ++k) __builtin_amdgcn_s_sleep(127); }
#endif
    f32x4 acc[2][2][4][2]; f32x4 binit[2][2];
    E.bias(cur, wr, wc, fq, binit);
#pragma unroll
    for (int a = 0; a < 2; ++a)
#pragma unroll
        for (int b = 0; b < 2; ++b)
#pragma unroll
            for (int m = 0; m < 4; ++m)
#pragma unroll
                for (int n = 0; n < 2; ++n) acc[a][b][m][n] = binit[b][n];
    bf16x8 At[4][2], B0[2][2], B1[2][2]; v8i32 At8[4], B08[2], B18[2];
    const char* cA = cur.A; const char* cB = cur.B;
    if constexpr (GATHER) { PG8_GOFF(vgC, cur); }
    PG8_STAGE(PG8_SB(0, 0), cB, voffB); PG8_STAGE(PG8_SB(0, 1), cB + hstepB, voffB); PG8_STAGEA(PG8_SA(0, 0), cA, 0); PG8_STAGEA(PG8_SA(0, 1), cA, 1);
    if (wr == 1) PG8_BAR;
    PG8_WAIT_V(2); PG8_BAR;
    PG8_STAGE(PG8_SB(1, 0), cB + kstep, voffB); PG8_STAGEA(PG8_SA(1, 0), cA + kstep, 0); PG8_STAGE(PG8_SB(1, 1), cB + hstepB + kstep, voffB);
    PG8_WAIT_V(6); PG8_BAR;
    for (;;) {
        const bool has_next = S.next(ui + 1, nxt);
        if constexpr (GATHER) { if (has_next && nxt.toks && tid < BM)
            __builtin_amdgcn_global_load_lds((const unsigned*)(nxt.toks + min(tid, nxt.rows - 1)), (PG8_LAS unsigned*)(lds + PG8_TOKL_OFF + (unsigned)wid * 256u), 4, 0, 0); }
        const char* nA = has_next ? nxt.A : cA; const char* nB = has_next ? nxt.B : cB;
        const int ntt = DUAL ? 2 * nt : nt;
        const char* cA2 = cur.A2; const char* cB2 = cur.B2;
#define PG8_TA(x) ((DUAL && (x) >= nt) ? cA2 + (size_t)((x) - nt) * kstep : cA + (size_t)(x) * kstep)
#define PG8_TB(x) ((DUAL && (x) >= nt) ? cB2 + (size_t)((x) - nt) * kstep : cB + (size_t)(x) * kstep)
#pragma unroll 1
        for (int t = 0; t < ntt; t += 2) {
            const bool last = (t == ntt - 2);
            if constexpr (DUAL) { if (t == nt) { int tm_ = threadIdx.x; asm volatile("" : "+v"(tm_)); const int wm_ = __builtin_amdgcn_readfirstlane(tm_ >> 6), lm_ = tm_ & 63;
                if (wr == 0) PG8_BAR;
                E.mid(acc, cur, wm_ >> 2, wm_ & 3, lm_ & 15, lm_ >> 4);
                if (wr == 1) PG8_BAR; } }
            const char* a1 = PG8_TA(t + 1);
            const char* a2 = last ? nA : PG8_TA(t + 2); const char* b2 = last ? nB : PG8_TB(t + 2);
            const char* a3 = a2 + kstep; const char* b3 = b2 + kstep;
            PG8_LDB(B0, 0, 0); PG8_LDB(B1, 0, 1); PG8_SCHED; PG8_LDA(At, 0, 0); PG8_STAGEA(PG8_SA(1, 1), a1, 1);
            if constexpr (GATHER) { if (last && has_next) {
                if (nxt.toks) { _Pragma("unroll") for (int _h = 0; _h < 2; ++_h) _Pragma("unroll") for (int _i = 0; _i < 2; ++_i) { int _R, _C; stage_rc(tid * 16 + _i * 8192, _R, _C);
                    vgC[_h][_i] = (unsigned)(tokl[_h * HALF + _R] * lda * ESZ + _C * 2); } }
                else { PG8_GOFF(vgC, nxt); } } }
            PG8_WAIT_V(8); PG8_WAIT_L(0); PG8_BAR; PG8_MMA(0, 0, At, B0); PG8_MMA(0, 1, At, B1); PG8_BAR; PG8_SCHED;
            PG8_LDA(At, 0, 1); PG8_STAGE(PG8_SB(0, 0), b2, voffB); PG8_STAGE(PG8_SB(0, 1), b2 + hstepB, voffB); PG8_STAGEA(PG8_SA(0, 0), a2, 0);
            PG8_WAIT_V(8); PG8_WAIT_L(0); PG8_BAR; PG8_MMA(1, 0, At, B0); PG8_MMA(1, 1, At, B1); PG8_BAR; PG8_SCHED;
            PG8_LDB(B0, 1, 0); PG8_LDB(B1, 1, 1); PG8_SCHED; PG8_LDA(At, 1, 0); PG8_STAGEA(PG8_SA(0, 1), a2, 1);
            PG8_WAIT_V(8); PG8_WAIT_L(0); PG8_BAR; PG8_MMA(0, 0, At, B0); PG8_MMA(0, 1, At, B1); PG8_BAR; PG8_SCHED;
            PG8_LDA(At, 1, 1); PG8_STAGE(PG8_SB(1, 0), b3, voffB); PG8_STAGE(PG8_SB(1, 1), b3 + hstepB, voffB); PG8_STAGEA(PG8_SA(1, 0), a3, 0);
            PG8_WAIT_V(8); PG8_WAIT_L(0); PG8_BAR; PG8_MMA(1, 0, At, B0); PG8_MMA(1, 1, At, B1); PG8_BAR; PG8_SCHED;
        }
        if (wr == 0) PG8_BAR;
        E.bias(has_next ? nxt : cur, wr, wc, fq, binit);
#ifdef PROBE_NOEPI
        if (noepi) {
#pragma unroll
            for (int a = 0; a < 2; ++a)
#pragma unroll
                for (int b = 0; b < 2; ++b)
#pragma unroll
                    for (int m = 0; m < 4; ++m)
#pragma unroll
                        for (int n = 0; n < 2; ++n) asm volatile("" :: "v"(acc[a][b][m][n]));
        } else
#endif
        { int te_ = threadIdx.x; asm volatile("" : "+v"(te_));
          const int we_ = __builtin_amdgcn_readfirstlane(te_ >> 6), le_ = te_ & 63; E(acc, cur, we_ >> 2, we_ & 3, le_ & 15, le_ >> 4); }
        if (!has_next) break;
#pragma unroll
        for (int a = 0; a < 2; ++a)
#pragma unroll
            for (int b = 0; b < 2; ++b)
#pragma unroll
                for (int m = 0; m < 4; ++m)
#pragma unroll
                    for (int n = 0; n < 2; ++n) acc[a][b][m][n] = binit[b][n];
        cur = nxt; cA = nA; cB = nB; ++ui;
        if (wr == 1) PG8_BAR;
    }
    PG8_WAIT_V(0);
    PG8_BAR;
#undef PG8_SA
#undef PG8_TA
#undef PG8_TB
#undef PG8_SB
#undef PG8_STAGE
#undef PG8_STAGEA
#undef PG8_GOFF
#undef PG8_LDA
#undef PG8_LDB
#undef PG8_MMA
#undef PG8_LD8
#undef PG8_WAIT_V
#undef PG8_WAIT_L
#undef PG8_BAR
#undef PG8_SCHED
}
}
namespace pg8 {
__device__ __forceinline__ float bf_lo(unsigned w) { return __uint_as_float(w << 16); }
__device__ __forceinline__ float bf_hi(unsigned w) { return __uint_as_float(w & 0xffff0000u); }
__device__ __forceinline__ float fast_sigmoid(float x) { return __builtin_amdgcn_rcpf(1.f + __builtin_amdgcn_exp2f(-1.4426950408889634f * x)); }
__device__ __forceinline__ void rope8(f32x4& v0, f32x4& v1, const float (&frq)[4], float pos) {
    float x[8] = {v0[0], v0[1], v0[2], v0[3], v1[0], v1[1], v1[2], v1[3]};
#pragma unroll
    for (int p = 0; p < 4; ++p) {
        float rev = pos * frq[p]; rev = __builtin_amdgcn_fractf(rev);
        const float s = __builtin_amdgcn_sinf(rev), c = __builtin_amdgcn_cosf(rev);
        const float a = x[2 * p], b = x[2 * p + 1];
        x[2 * p] = a * c - b * s; x[2 * p + 1] = b * c + a * s;
    }
    v0 = (f32x4){x[0], x[1], x[2], x[3]}; v1 = (f32x4){x[4], x[5], x[6], x[7]};
}
__device__ __forceinline__ float rope_freq(int idx, int half) {
    return __builtin_amdgcn_exp2f(-(float)idx / (float)half * 13.287712379549449f) * 0.15915494309189535f;
}
__device__ __forceinline__ u32x4 pack8(const f32x4& v0, const f32x4& v1) {
    u32x4 w; w.x = cvt_pk_bf16(v0[0], v0[1]); w.y = cvt_pk_bf16(v0[2], v0[3]); w.z = cvt_pk_bf16(v1[0], v1[1]); w.w = cvt_pk_bf16(v1[2], v1[3]); return w;
}

struct EpiProj {
    static constexpr bool PERM = true;
    bf16_t* proj; const float* b_gate; float* ssq; unsigned char* lat8;
    __device__ __forceinline__ void bias(const Unit& u, int wr, int wc, int fq, f32x4 (&b)[2][2]) const {
        const int cg = u.pn * BM + wc * 32 + 8 * fq - 4352;
#pragma unroll
        for (int bj = 0; bj < 2; ++bj)
#pragma unroll
            for (int n = 0; n < 2; ++n) b[bj][n] = u.pn >= 17 ? *(const f32x4*)(b_gate + cg + bj * HALF + 4 * n) : (f32x4){0.f, 0.f, 0.f, 0.f};
    }
    __device__ __forceinline__ void operator()(const f32x4 (&acc)[2][2][4][2], const Unit& u, int wr, int wc, int fr, int fq) const {
        const int pn = u.pn, row0 = u.row_off + wr * 64 + fr, colt = pn * BM + wc * 32 + 8 * fq;
        const bool t_rot = (pn >= 2 && pn <= 10) || pn == 15 || pn == 16, t_sig = pn >= 17, t_ssq = pn < 3;
        const float scl = (pn == 15 || pn == 16) ? 0.125f : 1.f;
        float frq[2][4];
#pragma unroll
        for (int bj = 0; bj < 2; ++bj) {
            const int cg = colt + bj * HALF; int H = 0, idx0 = 0;
            if (cg >= 640 && cg < 704) { H = 32; idx0 = (cg - 640) >> 1; }
            else if (cg >= 704 && cg < 768) { if (cg - 704 < 32) { H = 16; idx0 = (cg - 704) >> 1; } }
            else if (cg >= 768 && cg < 2816) { H = 64; idx0 = ((cg - 768) & 127) >> 1; }
            else if (cg >= 3840 && cg < 4352) { if (((cg - 3840) & 63) < 32) { H = 16; idx0 = ((cg - 3840) & 63) >> 1; } }
#pragma unroll
            for (int p = 0; p < 4; ++p) frq[bj][p] = H ? rope_freq(idx0 + p, H) : 0.f;
        }
#pragma unroll
        for (int ai = 0; ai < 2; ++ai)
#pragma unroll
            for (int m = 0; m < 4; ++m) {
                const int row = row0 + ai * HALF + m * 16; const float pos = (float)(row & 2047);
                bf16_t* rowp = proj + (size_t)row * 6400 + colt;
#pragma unroll
                for (int bj = 0; bj < 2; ++bj) {
                    f32x4 v0 = acc[ai][bj][m][0], v1 = acc[ai][bj][m][1];
                    if (t_ssq) {
                        float s = (v0[0] * v0[0] + v0[1] * v0[1]) + (v0[2] * v0[2] + v0[3] * v0[3]) + (v1[0] * v1[0] + v1[1] * v1[1]) + (v1[2] * v1[2] + v1[3] * v1[3]);
                        s += __shfl_xor(s, 16); s += __shfl_xor(s, 32);
                        if (fq == 0) ssq[(size_t)row * 24 + pn * 8 + bj * 4 + wc] = s;
                    }
                    if (t_rot) rope8(v0, v1, frq[bj], pos);
                    if (t_sig) {
#pragma unroll
                        for (int j = 0; j < 4; ++j) { v0[j] = fast_sigmoid(v0[j]); v1[j] = fast_sigmoid(v1[j]); } }
                    v0 = v0 * scl; v1 = v1 * scl;
                    if (t_sig) { int w0 = 0, w1 = 0;
                        w0 = __builtin_amdgcn_cvt_pk_fp8_f32(v0[0] * 256.f, v0[1] * 256.f, w0, false); w0 = __builtin_amdgcn_cvt_pk_fp8_f32(v0[2] * 256.f, v0[3] * 256.f, w0, true);
                        w1 = __builtin_amdgcn_cvt_pk_fp8_f32(v1[0] * 256.f, v1[1] * 256.f, w1, false); w1 = __builtin_amdgcn_cvt_pk_fp8_f32(v1[2] * 256.f, v1[3] * 256.f, w1, true);
                        u32x2 w; w.x = (unsigned)w0; w.y = (unsigned)w1; *(u32x2*)((unsigned char*)proj + (size_t)row * 12800 + 8704 + (colt - 4352) + bj * HALF) = w; }
                    else if (!(pn < 2 || (pn == 2 && bj == 0)))
                    *(u32x4*)(rowp + bj * HALF) = pack8(v0, v1);
                    if (pn < 2 || (pn == 2 && bj == 0)) { int w0 = 0, w1 = 0;
                        w0 = __builtin_amdgcn_cvt_pk_fp8_f32(v0[0] * 16.f, v0[1] * 16.f, w0, false); w0 = __builtin_amdgcn_cvt_pk_fp8_f32(v0[2] * 16.f, v0[3] * 16.f, w0, true);
                        w1 = __builtin_amdgcn_cvt_pk_fp8_f32(v1[0] * 16.f, v1[1] * 16.f, w1, false); w1 = __builtin_amdgcn_cvt_pk_fp8_f32(v1[2] * 16.f, v1[3] * 16.f, w1, true);
                        u32x2 w; w.x = (unsigned)w0; w.y = (unsigned)w1; *(u32x2*)(lat8 + (size_t)row * 640 + colt + bj * HALF) = w; }
                }
            }
    }
};

struct EpiMla {
    static constexpr bool PERM = true;
    bf16_t* out; int ldc; const float* ssq; int s0, ns; float invn; int rope;
    __device__ __forceinline__ void bias(const Unit&, int, int, int, f32x4 (&b)[2][2]) const { b[0][0] = b[0][1] = b[1][0] = b[1][1] = (f32x4){0.f, 0.f, 0.f, 0.f}; }
    __device__ __forceinline__ void operator()(const f32x4 (&acc)[2][2][4][2], const Unit& u, int wr, int wc, int fr, int fq) const {
        const int row0 = u.row_off + wr * 64 + fr, colt = u.pn * BM + wc * 32 + 8 * fq;
        float frq[2][4];
#pragma unroll
        for (int bj = 0; bj < 2; ++bj) { const int d = (colt + bj * HALF) % 192; const bool rt = rope && d >= 128;
#pragma unroll
            for (int p = 0; p < 4; ++p) frq[bj][p] = rt ? rope_freq(((d - 128) >> 1) + p, 32) : 0.f; }
#pragma unroll
        for (int ai = 0; ai < 2; ++ai) {
            f32x4 pa[4], pb[4], pc[4];
#pragma unroll
            for (int m = 0; m < 4; ++m) { const f32x4* sp = (const f32x4*)(ssq + (size_t)(row0 + ai * HALF + m * 16) * 24 + s0);
                pa[m] = sp[0]; pb[m] = sp[1]; pc[m] = (ns > 8) ? sp[2] : (f32x4){0.f, 0.f, 0.f, 0.f}; }
#pragma unroll
            for (int m = 0; m < 4; ++m) {
                const int row = row0 + ai * HALF + m * 16; const float pos = (float)(row & 2047);
                const f32x4 a = pa[m], b = pb[m], c = pc[m];
                const float tot = ((a[0] + a[1]) + (a[2] + a[3])) + ((b[0] + b[1]) + (b[2] + b[3])) + ((c[0] + c[1]) + (c[2] + c[3]));
                const float r = __builtin_amdgcn_rsqf(tot * invn + 1e-6f);
                bf16_t* rowp = out + (size_t)row * ldc + colt;
#pragma unroll
                for (int bj = 0; bj < 2; ++bj) {
                    f32x4 v0 = acc[ai][bj][m][0] * r, v1 = acc[ai][bj][m][1] * r;
                    if (rope) rope8(v0, v1, frq[bj], pos);
                    *(u32x4*)(rowp + bj * HALF) = pack8(v0, v1);
                }
            }
            asm volatile("" ::: "memory");
        }
    }
};

struct EpiGate {
    static constexpr bool PERM = true;
    bf16_t* out; const bf16_t* prev; const bf16_t* gate; unsigned char* out8;
    __device__ __forceinline__ void bias(const Unit&, int, int, int, f32x4 (&b)[2][2]) const { b[0][0] = b[0][1] = b[1][0] = b[1][1] = (f32x4){0.f, 0.f, 0.f, 0.f}; }
    __device__ __forceinline__ void operator()(const f32x4 (&acc)[2][2][4][2], const Unit& u, int wr, int wc, int fr, int fq) const {
        const int row0 = u.row_off + wr * 64 + fr, colt = u.pn * BM + wc * 32 + 8 * fq;
#pragma unroll
        for (int ai = 0; ai < 2; ++ai) {
            u32x4 gg[4][2], qq[4][2];
#pragma unroll
            for (int m = 0; m < 4; ++m)
#pragma unroll
                for (int bj = 0; bj < 2; ++bj) { const int row = row0 + ai * HALF + m * 16, col = colt + bj * HALF;
                    gg[m][bj] = *(const u32x4*)(gate + (size_t)row * 6400 + col);
                    qq[m][bj] = prev ? *(const u32x4*)(prev + (size_t)row * 1024 + col) : (u32x4){0u, 0u, 0u, 0u}; }
#pragma unroll
            for (int m = 0; m < 4; ++m)
#pragma unroll
                for (int bj = 0; bj < 2; ++bj) { const int row = row0 + ai * HALF + m * 16, col = colt + bj * HALF;
                    const u32x4 g = gg[m][bj], q = qq[m][bj];
                    f32x4 v0 = acc[ai][bj][m][0], v1 = acc[ai][bj][m][1];
                    v0[0] = fmaf(v0[0], bf_lo(g.x), bf_lo(q.x)); v0[1] = fmaf(v0[1], bf_hi(g.x), bf_hi(q.x)); v0[2] = fmaf(v0[2], bf_lo(g.y), bf_lo(q.y)); v0[3] = fmaf(v0[3], bf_hi(g.y), bf_hi(q.y));
                    v1[0] = fmaf(v1[0], bf_lo(g.z), bf_lo(q.z)); v1[1] = fmaf(v1[1], bf_hi(g.z), bf_hi(q.z)); v1[2] = fmaf(v1[2], bf_lo(g.w), bf_lo(q.w)); v1[3] = fmaf(v1[3], bf_hi(g.w), bf_hi(q.w));
                    if (out8) { int w0 = 0, w1 = 0;
#pragma unroll
                        for (int j = 0; j < 4; ++j) { v0[j] = __builtin_amdgcn_fmed3f(v0[j] * 64.f, -448.f, 448.f); v1[j] = __builtin_amdgcn_fmed3f(v1[j] * 64.f, -448.f, 448.f); }
                        w0 = __builtin_amdgcn_cvt_pk_fp8_f32(v0[0], v0[1], w0, false); w0 = __builtin_amdgcn_cvt_pk_fp8_f32(v0[2], v0[3], w0, true);
                        w1 = __builtin_amdgcn_cvt_pk_fp8_f32(v1[0], v1[1], w1, false); w1 = __builtin_amdgcn_cvt_pk_fp8_f32(v1[2], v1[3], w1, true);
                        u32x2 w; w.x = (unsigned)w0; w.y = (unsigned)w1; *(u32x2*)(out8 + (size_t)row * 1024 + col) = w; }
                    else *(u32x4*)(out + (size_t)row * 1024 + col) = pack8(v0, v1); }
            asm volatile("" ::: "memory");
        }
    }
};

struct EpiGate2 {
    static constexpr bool PERM = true;
    const unsigned char* g8; unsigned char* out8;
    __device__ __forceinline__ void bias(const Unit&, int, int, int, f32x4 (&b)[2][2]) const { b[0][0] = b[0][1] = b[1][0] = b[1][1] = (f32x4){0.f, 0.f, 0.f, 0.f}; }
    __device__ __forceinline__ static void unpack8(const u32x2& w, f32x4& lo, f32x4& hi) {
        const f32x2 a = __builtin_amdgcn_cvt_pk_f32_fp8((int)w.x, false), b = __builtin_amdgcn_cvt_pk_f32_fp8((int)w.x, true), c = __builtin_amdgcn_cvt_pk_f32_fp8((int)w.y, false), d = __builtin_amdgcn_cvt_pk_f32_fp8((int)w.y, true);
        lo = (f32x4){a.x, a.y, b.x, b.y}; hi = (f32x4){c.x, c.y, d.x, d.y};
    }
    __device__ __forceinline__ void mid(f32x4 (&acc)[2][2][4][2], const Unit& u, int wr, int wc, int fr, int fq) const {
        const int row0 = u.row_off + wr * 64 + fr, colt = u.pn * BM + wc * 32 + 8 * fq;
#pragma unroll
        for (int ai = 0; ai < 2; ++ai) {
            u32x2 xa[4][2], xb[4][2];
#pragma unroll
            for (int m = 0; m < 4; ++m)
#pragma unroll
                for (int bj = 0; bj < 2; ++bj) { const size_t o = (size_t)(row0 + ai * HALF + m * 16) * 12800 + colt + bj * HALF;
                    xa[m][bj] = *(const u32x2*)(g8 + o); xb[m][bj] = *(const u32x2*)(g8 + o + 1024); }
#pragma unroll
            for (int m = 0; m < 4; ++m)
#pragma unroll
                for (int bj = 0; bj < 2; ++bj) { f32x4 a0, a1, r0, r1; unpack8(xa[m][bj], a0, a1); unpack8(xb[m][bj], r0, r1);
#pragma unroll
                    for (int j = 0; j < 4; ++j) { r0[j] = __builtin_amdgcn_rcpf(__builtin_amdgcn_fmed3f(r0[j], 0.001953125f, 1.0e30f)); r1[j] = __builtin_amdgcn_rcpf(__builtin_amdgcn_fmed3f(r1[j], 0.001953125f, 1.0e30f)); }
                    acc[ai][bj][m][0] = acc[ai][bj][m][0] * (a0 * r0); acc[ai][bj][m][1] = acc[ai][bj][m][1] * (a1 * r1); }
            asm volatile("" ::: "memory");
        }
    }
    __device__ __forceinline__ void operator()(const f32x4 (&acc)[2][2][4][2], const Unit& u, int wr, int wc, int fr, int fq) const {
        const int row0 = u.row_off + wr * 64 + fr, colt = u.pn * BM + wc * 32 + 8 * fq;
#pragma unroll
        for (int ai = 0; ai < 2; ++ai) {
            u32x2 xb[4][2];
#pragma unroll
            for (int m = 0; m < 4; ++m)
#pragma unroll
                for (int bj = 0; bj < 2; ++bj) xb[m][bj] = *(const u32x2*)(g8 + (size_t)(row0 + ai * HALF + m * 16) * 12800 + colt + bj * HALF + 1024);
#pragma unroll
            for (int m = 0; m < 4; ++m)
#pragma unroll
                for (int bj = 0; bj < 2; ++bj) { const int row = row0 + ai * HALF + m * 16, col = colt + bj * HALF; f32x4 g0, g1; unpack8(xb[m][bj], g0, g1);
                    f32x4 v0 = acc[ai][bj][m][0] * (g0 * 0.25f), v1 = acc[ai][bj][m][1] * (g1 * 0.25f); int w0 = 0, w1 = 0;
#pragma unroll
                    for (int j = 0; j < 4; ++j) { v0[j] = __builtin_amdgcn_fmed3f(v0[j], -448.f, 448.f); v1[j] = __builtin_amdgcn_fmed3f(v1[j], -448.f, 448.f); }
                    w0 = __builtin_amdgcn_cvt_pk_fp8_f32(v0[0], v0[1], w0, false); w0 = __builtin_amdgcn_cvt_pk_fp8_f32(v0[2], v0[3], w0, true);
                    w1 = __builtin_amdgcn_cvt_pk_fp8_f32(v1[0], v1[1], w1, false); w1 = __builtin_amdgcn_cvt_pk_fp8_f32(v1[2], v1[3], w1, true);
                    u32x2 w; w.x = (unsigned)w0; w.y = (unsigned)w1; *(u32x2*)(out8 + (size_t)row * 1024 + col) = w; }
            asm volatile("" ::: "memory");
        }
    }
};

struct EpiX1 {
    static constexpr bool PERM = false;
    const float* x; bf16_t* x1; float* ssq1;
    __device__ __forceinline__ void bias(const Unit&, int, int, int, f32x4 (&b)[2][2]) const { b[0][0] = b[0][1] = b[1][0] = b[1][1] = (f32x4){0.f, 0.f, 0.f, 0.f}; }
    __device__ __forceinline__ void operator()(const f32x4 (&acc)[2][2][4][2], const Unit& u, int wr, int wc, int fr, int fq) const {
        const int row0 = u.row_off + wr * 64 + fr, col0 = u.pn * BM + wc * 32 + 4 * fq;
#pragma unroll
        for (int ai = 0; ai < 2; ++ai) {
            f32x4 bs[4][2][2];
#pragma unroll
            for (int m = 0; m < 4; ++m) { const size_t off = (size_t)(row0 + ai * HALF + m * 16) * 1024 + col0;
#pragma unroll
                for (int bj = 0; bj < 2; ++bj)
#pragma unroll
                    for (int n = 0; n < 2; ++n) bs[m][bj][n] = *(const f32x4*)(x + off + bj * HALF + n * 16); }
#pragma unroll
            for (int m = 0; m < 4; ++m) { const int row = row0 + ai * HALF + m * 16; const size_t off = (size_t)row * 1024 + col0; float s = 0.f;
#pragma unroll
                for (int bj = 0; bj < 2; ++bj)
#pragma unroll
                    for (int n = 0; n < 2; ++n) { const f32x4 v = bs[m][bj][n] + acc[ai][bj][m][n]; u32x2 w; w.x = cvt_pk_bf16(v[0], v[1]); w.y = cvt_pk_bf16(v[2], v[3]); *(u32x2*)(x1 + off + bj * HALF + n * 16) = w; s += (v[0] * v[0] + v[1] * v[1]) + (v[2] * v[2] + v[3] * v[3]); }
                s += __shfl_xor(s, 16); s += __shfl_xor(s, 32);
                if (fq == 0) ssq1[(size_t)row * 16 + u.pn * 4 + wc] = s; }
            asm volatile("" ::: "memory");
        }
    }
};

struct EpiAct {
    static constexpr bool PERM = true;
    bf16_t* act; const float* bgu;
    __device__ __forceinline__ void bias(const Unit& u, int wr, int wc, int fq, f32x4 (&b)[2][2]) const {
        const float* bg = bgu + (size_t)u.e * 2048 + u.pn * HALF + wc * 32 + 8 * fq;
#pragma unroll
        for (int n = 0; n < 2; ++n) { b[0][n] = *(const f32x4*)(bg + 4 * n); b[1][n] = *(const f32x4*)(bg + 1024 + 4 * n); }
    }
    __device__ __forceinline__ void operator()(const f32x4 (&acc)[2][2][4][2], const Unit& u, int wr, int wc, int fr, int fq) const {
        const int rr0 = wr * 64 + fr, cb = u.pn * HALF + wc * 32 + 8 * fq;
#pragma unroll
        for (int ai = 0; ai < 2; ++ai)
#pragma unroll
            for (int m = 0; m < 4; ++m) {
                const int rr = rr0 + ai * HALF + m * 16;
                f32x4 o[2];
#pragma unroll
                for (int n = 0; n < 2; ++n) { const f32x4 g = acc[ai][0][m][n], l = acc[ai][1][m][n]; f32x4 gt, ln, e;
#pragma unroll
                    for (int j = 0; j < 4; ++j) { gt[j] = __builtin_amdgcn_fmed3f(g[j], -3.0e38f, 7.0f); ln[j] = __builtin_amdgcn_fmed3f(l[j], -7.0f, 7.0f); }
                    e = gt * (-1.702f * 1.4426950408889634f);
#pragma unroll
                    for (int j = 0; j < 4; ++j) e[j] = __builtin_amdgcn_exp2f(e[j]);
                    e = e + 1.0f;
#pragma unroll
                    for (int j = 0; j < 4; ++j) e[j] = __builtin_amdgcn_rcpf(e[j]);
                    o[n] = (ln * 4.0f + 4.0f) * (gt * e); }
                if (rr < u.rows) { int w0 = 0, w1 = 0;
                    w0 = __builtin_amdgcn_cvt_pk_fp8_f32(o[0][0], o[0][1], w0, false); w0 = __builtin_amdgcn_cvt_pk_fp8_f32(o[0][2], o[0][3], w0, true);
                    w1 = __builtin_amdgcn_cvt_pk_fp8_f32(o[1][0], o[1][1], w1, false); w1 = __builtin_amdgcn_cvt_pk_fp8_f32(o[1][2], o[1][3], w1, true);
                    u32x2 w; w.x = (unsigned)w0; w.y = (unsigned)w1; *(u32x2*)((unsigned char*)act + (size_t)(u.row_off + rr) * 1024 + cb) = w; }
            }
    }
};

struct EpiY {
    static constexpr bool PERM = true;
    bf16_t* y; const float* bdn;
    __device__ __forceinline__ void bias(const Unit& u, int wr, int wc, int fq, f32x4 (&b)[2][2]) const {
        const float* bd = bdn + (size_t)u.e * 1024 + u.pn * BM + wc * 32 + 8 * fq;
#pragma unroll
        for (int bj = 0; bj < 2; ++bj)
#pragma unroll
            for (int n = 0; n < 2; ++n) b[bj][n] = *(const f32x4*)(bd + bj * HALF + 4 * n);
    }
    __device__ __forceinline__ void operator()(const f32x4 (&acc)[2][2][4][2], const Unit& u, int wr, int wc, int fr, int fq) const {
        const int rr0 = wr * 64 + fr, colt = u.pn * BM + wc * 32 + 16 * (fq >> 1), odd = fq & 1;
#pragma unroll
        for (int ai = 0; ai < 2; ++ai)
#pragma unroll
            for (int mp = 0; mp < 4; mp += 2) {
                const int rr = rr0 + ai * HALF + (mp + odd) * 16;
#pragma unroll
                for (int bj = 0; bj < 2; ++bj) { unsigned w[2][2];
#pragma unroll
                    for (int d = 0; d < 2; ++d) { const f32x4 v0 = acc[ai][bj][mp + d][0] * 16.f, v1 = acc[ai][bj][mp + d][1] * 16.f; int w0 = 0, w1 = 0;
                        w0 = __builtin_amdgcn_cvt_pk_fp8_f32(v0[0], v0[1], w0, false); w0 = __builtin_amdgcn_cvt_pk_fp8_f32(v0[2], v0[3], w0, true);
                        w1 = __builtin_amdgcn_cvt_pk_fp8_f32(v1[0], v1[1], w1, false); w1 = __builtin_amdgcn_cvt_pk_fp8_f32(v1[2], v1[3], w1, true);
                        w[d][0] = (unsigned)w0; w[d][1] = (unsigned)w1; }
                    const auto s0 = __builtin_amdgcn_permlane16_swap(w[0][0], w[1][0], false, false), s1 = __builtin_amdgcn_permlane16_swap(w[0][1], w[1][1], false, false);
                    if (rr < u.rows) { u32x4 o; o.x = s0[0]; o.y = s1[0]; o.z = s0[1]; o.w = s1[1]; *(u32x4*)((unsigned char*)y + (size_t)(u.row_off + rr) * 1024 + colt + bj * HALF) = o; }
                }
            }
    }
};
}
namespace att {
using bf16 = unsigned short;
using bf16x8 = __attribute__((ext_vector_type(8))) short;
using s16x4  = __attribute__((ext_vector_type(4))) short;
using f32x16 = __attribute__((ext_vector_type(16))) float;
using u32x4  = __attribute__((ext_vector_type(4))) unsigned;
constexpr int D = 128, NW = 8, QBLK = 32, KVBLK = 64;
constexpr float THR = 8.f;
constexpr size_t SHM_V = KVBLK * D * 2, SHM_K = KVBLK * D * 2, SHM_KR = KVBLK * 64 * 2;
constexpr size_t OFF_V = 0, OFF_K = 2 * SHM_V, OFF_KR = OFF_K + 2 * SHM_K, OFF_WS = OFF_KR + 2 * SHM_KR, OFF_QP = OFF_WS + NW * 64 * 4, SHM_ATTN = OFF_QP + NW * 4096;
#define KSWZ(row, colB) ((row) * 256 + ((colB) ^ (((row) & 15) << 4)))
#define KRSWZ(row, colB) ((row) * 128 + ((colB) ^ ((((row) >> 1) & 7) << 4)))
#define SBAR() __builtin_amdgcn_sched_barrier(0)
__device__ __forceinline__ int crow(int r, int hi) { return (r & 3) + 8 * (r >> 2) + 4 * hi; }
__device__ __forceinline__ unsigned cvtpk(float lo, float hi) { unsigned r; asm volatile("v_cvt_pk_bf16_f32 %0, %1, %2" : "=v"(r) : "v"(lo), "v"(hi)); return r; }

__device__ __forceinline__ void apply_mask(f32x16& p0, f32x16& p1, unsigned w) {
    const unsigned NEG = 0xff800000u;
#pragma unroll
    for (int r = 0; r < 16; ++r) {
        const unsigned t0 = (unsigned)__builtin_amdgcn_sbfe((int)w, r, 1), t1 = (unsigned)__builtin_amdgcn_sbfe((int)w, 16 + r, 1);
        p0[r] = __uint_as_float((__float_as_uint(p0[r]) & t0) | (NEG & ~t0));
        p1[r] = __uint_as_float((__float_as_uint(p1[r]) & t1) | (NEG & ~t1));
    }
}
template <int MODE>
__device__ __forceinline__ void partialSM(f32x16& p0, f32x16& p1, float& m_reg, float& mn, float& alpha) {
    constexpr float SCALE = MODE == 0 ? 0.07216878364870322f : 0.08838834764831845f;
    constexpr float C = SCALE * 1.4426950408889634f;
    float pmax = p0[0];
#pragma unroll
    for (int r = 1; r < 16; ++r) pmax = fmaxf(pmax, p0[r]);
#pragma unroll
    for (int r = 0; r < 16; ++r) pmax = fmaxf(pmax, p1[r]);
    { auto rr = __builtin_amdgcn_permlane32_swap(__float_as_uint(pmax), __float_as_uint(pmax), false, false);
      pmax = fmaxf(__uint_as_float(rr[0]), __uint_as_float(rr[1])); }
    if (__builtin_expect(__all(pmax - m_reg <= THR / SCALE), 1)) { mn = m_reg; alpha = 1.f; }
    else { mn = fmaxf(m_reg, pmax); alpha = __builtin_amdgcn_exp2f((m_reg - mn) * C); m_reg = mn; }
    const float mnC = -mn * C;
#pragma unroll
    for (int r = 0; r < 16; ++r) p0[r] = fmaf(p0[r], C, mnC);
#pragma unroll
    for (int r = 0; r < 16; ++r) p1[r] = fmaf(p1[r], C, mnC);
#pragma unroll
    for (int r = 0; r < 16; ++r) p0[r] = __builtin_amdgcn_exp2f(p0[r]);
}
__device__ __forceinline__ void finishSM(f32x16& p0, f32x16& p1, float alpha, float& l_reg, bf16x8& pa0, bf16x8& pa1, bf16x8& pa2, bf16x8& pa3) {
#pragma unroll
    for (int r = 0; r < 16; ++r) p1[r] = __builtin_amdgcn_exp2f(p1[r]);
    float ps = 0;
#pragma unroll
    for (int r = 0; r < 16; ++r) ps += p0[r];
#pragma unroll
    for (int r = 0; r < 16; ++r) ps += p1[r];
    { auto rr = __builtin_amdgcn_permlane32_swap(__float_as_uint(ps), __float_as_uint(ps), false, false);
      ps = __uint_as_float(rr[0]) + __uint_as_float(rr[1]); }
    l_reg = l_reg * alpha + ps;
#define PK4(P, BASE, OUT) do { unsigned a0 = cvtpk(P[BASE + 0], P[BASE + 1]), a1 = cvtpk(P[BASE + 2], P[BASE + 3]);   \
    unsigned b0 = cvtpk(P[BASE + 4], P[BASE + 5]), b1 = cvtpk(P[BASE + 6], P[BASE + 7]);                              \
    auto r0 = __builtin_amdgcn_permlane32_swap(a0, b0, false, false); auto r1 = __builtin_amdgcn_permlane32_swap(a1, b1, false, false); \
    u32x4 w = {r0[0], r1[0], r0[1], r1[1]}; OUT = *reinterpret_cast<bf16x8*>(&w); } while (0)
    PK4(p0, 0, pa0); PK4(p0, 8, pa1); PK4(p1, 0, pa2); PK4(p1, 8, pa3);
#undef PK4
}
template <int MODE>
__device__ __forceinline__ void qkt(f32x16& p0, f32x16& p1, const char* Ks, const char* Krs, const bf16x8* qr, const char* qpark, int r32, int hi) {
    constexpr int NREG = MODE == 0 ? 8 : 6;
    p0 = f32x16{}; p1 = f32x16{};
#pragma unroll
    for (int d0 = 0; d0 < 8; ++d0) { const int cb = (d0 * 16 + hi * 8) * 2;
        bf16x8 b0 = *reinterpret_cast<const bf16x8*>(Ks + KSWZ(r32, cb));
        bf16x8 b1 = *reinterpret_cast<const bf16x8*>(Ks + KSWZ(32 + r32, cb));
        const bf16x8 qv = d0 < NREG ? qr[d0 < NREG ? d0 : 0] : *reinterpret_cast<const bf16x8*>(qpark + (d0 - NREG) * 1024);
        p0 = __builtin_amdgcn_mfma_f32_32x32x16_bf16(b0, qv, p0, 0, 0, 0);
        p1 = __builtin_amdgcn_mfma_f32_32x32x16_bf16(b1, qv, p1, 0, 0, 0); }
    if constexpr (MODE == 0) {
#pragma unroll
        for (int d0 = 0; d0 < 4; ++d0) { const int cb = (d0 * 16 + hi * 8) * 2;
            bf16x8 b0 = *reinterpret_cast<const bf16x8*>(Krs + KRSWZ(r32, cb));
            bf16x8 b1 = *reinterpret_cast<const bf16x8*>(Krs + KRSWZ(32 + r32, cb));
            const bf16x8 qv = *reinterpret_cast<const bf16x8*>(qpark + d0 * 1024);
            p0 = __builtin_amdgcn_mfma_f32_32x32x16_bf16(b0, qv, p0, 0, 0, 0);
            p1 = __builtin_amdgcn_mfma_f32_32x32x16_bf16(b1, qv, p1, 0, 0, 0); }
    }
}
__device__ __forceinline__ int v_st(int k, int c) { const int kk = (k & ~0xC) | ((k & 4) << 1) | ((k & 8) >> 1); return ((kk >> 3) * 4 + (c >> 5)) * 512 + ((kk & 7) * 32 + (c & 31)) * 2; }
__device__ __forceinline__ int v_rd_base(int lane) { return ((lane & 3) << 3) | (((lane >> 2) & 3) << 6) | (((lane >> 4) & 1) << 5) | (((lane >> 5) & 1) << 8); }
constexpr int v_rd_off(int d0, int ks, int half) { return d0 * 512 + ks * 4096 + half * 2048; }
template <int OFF> __device__ __forceinline__ s16x4 tr_read(int vb) {
    s16x4 r; asm volatile("ds_read_b64_tr_b16 %0, %1 offset:%2" : "=&v"(r) : "v"(vb), "i"(OFF) : "memory"); return r;
}
template <int D0> __device__ __forceinline__ void pv_one(f32x16& od, int vb, bf16x8 pa0, bf16x8 pa1, bf16x8 pa2, bf16x8 pa3) {
    const s16x4 l0 = tr_read<v_rd_off(D0, 0, 0)>(vb), h0 = tr_read<v_rd_off(D0, 0, 1)>(vb), l1 = tr_read<v_rd_off(D0, 1, 0)>(vb), h1 = tr_read<v_rd_off(D0, 1, 1)>(vb);
    const s16x4 l2 = tr_read<v_rd_off(D0, 2, 0)>(vb), h2 = tr_read<v_rd_off(D0, 2, 1)>(vb), l3 = tr_read<v_rd_off(D0, 3, 0)>(vb), h3 = tr_read<v_rd_off(D0, 3, 1)>(vb);
    asm volatile("s_waitcnt lgkmcnt(0)" ::: "memory"); SBAR();
#define PK(L, H) (bf16x8){L[0], L[1], L[2], L[3], H[0], H[1], H[2], H[3]}
    od = __builtin_amdgcn_mfma_f32_32x32x16_bf16(pa0, PK(l0, h0), od, 0, 0, 0);
    od = __builtin_amdgcn_mfma_f32_32x32x16_bf16(pa1, PK(l1, h1), od, 0, 0, 0);
    od = __builtin_amdgcn_mfma_f32_32x32x16_bf16(pa2, PK(l2, h2), od, 0, 0, 0);
    od = __builtin_amdgcn_mfma_f32_32x32x16_bf16(pa3, PK(l3, h3), od, 0, 0, 0);
#undef PK
}
__device__ __forceinline__ void pv_d0(f32x16* o, int vb, bf16x8 pa0, bf16x8 pa1, bf16x8 pa2, bf16x8 pa3) {
    pv_one<0>(o[0], vb, pa0, pa1, pa2, pa3); pv_one<1>(o[1], vb, pa0, pa1, pa2, pa3); pv_one<2>(o[2], vb, pa0, pa1, pa2, pa3); pv_one<3>(o[3], vb, pa0, pa1, pa2, pa3);
}

template <int MODE, int LDQ, int LDK>
__device__ __forceinline__ void attn_unit(const bf16* __restrict__ Qb, const bf16* __restrict__ Kh, const bf16* __restrict__ Vh, const bf16* __restrict__ Krh,
                                          const unsigned* __restrict__ Mk, unsigned char* __restrict__ Ob, int i0, char* lds) {
    constexpr int NQ = MODE == 0 ? 12 : 8;
    int tid_ = threadIdx.x; asm volatile("" : "+v"(tid_));
    const int tid = tid_, wid = __builtin_amdgcn_readfirstlane(tid >> 6), lane = tid & 63, r32 = lane & 31, hi = lane >> 5;
    char* V_lds = lds + OFF_V; char* K_lds = lds + OFF_K; char* Kr_lds = lds + OFF_KR;
    float* ws = (float*)(lds + OFF_WS) + wid * 64; float* li_l = ws; float* al_l = ws + 32;
    constexpr int NREG = MODE == 0 ? 8 : 6;
    float m_reg = -1e30f, l_reg = 0; f32x16 o[4] = {}; bf16x8 qr[NREG];
    const bf16* Qw = Qb + (long)(wid * QBLK + r32) * LDQ + hi * 8;
    char* qpark = lds + OFF_QP + wid * 4096 + lane * 16;
#pragma unroll
    for (int d0 = 0; d0 < NREG; ++d0) qr[d0] = *reinterpret_cast<const bf16x8*>(Qw + d0 * 16);
#pragma unroll
    for (int d0 = NREG; d0 < NQ; ++d0) *reinterpret_cast<bf16x8*>(qpark + (d0 - NREG) * 1024) = *reinterpret_cast<const bf16x8*>(Qw + d0 * 16);
    const int sr = tid >> 4, sc = (tid & 15) * 8, vst0 = v_st(sr, sc), vst1 = v_st(32 + sr, sc);
    const int krr = tid >> 3, krc = (tid & 7) * 8;
    const int vb0 = (int)(uintptr_t)V_lds + v_rd_base(lane);
    const int NT = (i0 + 256) / KVBLK;
    const int jvis = (i0 >> 6) + (wid >> 1);
    const unsigned* Mw = Mk + ((size_t)(wid * QBLK + r32) * 32) * 2 + hi;
    struct { bf16x8 vs0, vs1, ks0, ks1, kr; } st;
#define SLOAD(k0) do { st.vs0 = *reinterpret_cast<const bf16x8*>(&Vh[(long)((k0) + sr) * LDK + sc]); st.vs1 = *reinterpret_cast<const bf16x8*>(&Vh[(long)((k0) + 32 + sr) * LDK + sc]); \
    st.ks0 = *reinterpret_cast<const bf16x8*>(&Kh[(long)((k0) + sr) * LDK + sc]); st.ks1 = *reinterpret_cast<const bf16x8*>(&Kh[(long)((k0) + 32 + sr) * LDK + sc]); \
    if constexpr (MODE == 0) st.kr = *reinterpret_cast<const bf16x8*>(&Krh[(long)((k0) + krr) * 6400 + krc]); } while (0)
#define SWRITE(b) do { *(bf16x8*)(V_lds + (b) * SHM_V + vst0) = st.vs0; *(bf16x8*)(V_lds + (b) * SHM_V + vst1) = st.vs1; const int kc = sc * 2; \
    *(bf16x8*)(K_lds + (b) * SHM_K + KSWZ(sr, kc)) = st.ks0; *(bf16x8*)(K_lds + (b) * SHM_K + KSWZ(32 + sr, kc)) = st.ks1; \
    if constexpr (MODE == 0) *(bf16x8*)(Kr_lds + (b) * SHM_KR + KRSWZ(krr, krc * 2)) = st.kr; } while (0)
#define RESC(a) do { if (__any((a) < 1.f)) { if (hi == 0) al_l[r32] = (a); asm volatile("s_waitcnt lgkmcnt(0)" ::: "memory"); \
    _Pragma("unroll") for (int d = 0; d < 4; ++d) _Pragma("unroll") for (int r = 0; r < 16; ++r) o[d][r] *= al_l[crow(r, hi)]; } } while (0)
#define MASKT(P0, P1, j, MWORD) do { if constexpr (MODE == 0) { if ((j) > jvis) { asm volatile("" ::: "memory");   \
        _Pragma("unroll") for (int r = 0; r < 16; ++r) { P0[r] = -INFINITY; P1[r] = -INFINITY; } } } \
    else { apply_mask(P0, P1, MWORD); } } while (0)
#define MLOAD(j) (MODE == 1 ? Mw[(j) * 2] : 0u)
    f32x16 pA0, pA1, pB0, pB1; float mnA, mnB, alA, alB; bf16x8 pa0, pa1, pa2, pa3;
    SLOAD(0); asm volatile("s_waitcnt vmcnt(0)" ::: "memory"); SWRITE(0); __syncthreads();
    unsigned mwA = MLOAD(0), mwB = MLOAD(1);
    qkt<MODE>(pA0, pA1, K_lds, Kr_lds, qr, qpark, r32, hi); MASKT(pA0, pA1, 0, mwA); partialSM<MODE>(pA0, pA1, m_reg, mnA, alA);
    SLOAD(KVBLK);
    SWRITE(1); __syncthreads();
    for (int j = 1; j + 1 < NT; j += 2) {
        SBAR(); qkt<MODE>(pB0, pB1, K_lds + SHM_K, Kr_lds + SHM_KR, qr, qpark, r32, hi);
        finishSM(pA0, pA1, alA, l_reg, pa0, pa1, pa2, pa3); SBAR();
        SLOAD((j + 1) * KVBLK); mwA = MLOAD(j + 1); SBAR();
        pv_d0(o, vb0, pa0, pa1, pa2, pa3); MASKT(pB0, pB1, j, mwB); partialSM<MODE>(pB0, pB1, m_reg, mnB, alB);
        __syncthreads(); SWRITE(0);
        RESC(alB); __syncthreads();
        SBAR(); qkt<MODE>(pA0, pA1, K_lds, Kr_lds, qr, qpark, r32, hi);
        finishSM(pB0, pB1, alB, l_reg, pa0, pa1, pa2, pa3); SBAR();
        SLOAD((j + 2) * KVBLK); mwB = MLOAD(j + 2); SBAR();
        pv_d0(o, vb0 + (int)SHM_V, pa0, pa1, pa2, pa3); MASKT(pA0, pA1, j + 1, mwA); partialSM<MODE>(pA0, pA1, m_reg, mnA, alA);
        __syncthreads(); SWRITE(1);
        RESC(alA); __syncthreads();
    }
    SBAR(); qkt<MODE>(pB0, pB1, K_lds + SHM_K, Kr_lds + SHM_KR, qr, qpark, r32, hi);
    finishSM(pA0, pA1, alA, l_reg, pa0, pa1, pa2, pa3); SBAR();
    pv_d0(o, vb0, pa0, pa1, pa2, pa3); MASKT(pB0, pB1, NT - 1, mwB); partialSM<MODE>(pB0, pB1, m_reg, mnB, alB);
    __syncthreads(); RESC(alB);
    finishSM(pB0, pB1, alB, l_reg, pa0, pa1, pa2, pa3); SBAR();
    pv_d0(o, vb0 + (int)SHM_V, pa0, pa1, pa2, pa3);
    if (hi == 0) li_l[r32] = l_reg; asm volatile("s_waitcnt lgkmcnt(0)" ::: "memory");
    unsigned char* Ow = Ob + (long)(wid * QBLK) * 2048;
    const int qi = lane & 3;
    const unsigned selA = (qi & 1) ? 0x03070105u : 0x06020400u, selB = (qi & 2) ? 0x03020706u : 0x05040100u;
#pragma unroll
    for (int rg = 0; rg < 4; ++rg) {
        float rinv[4];
#pragma unroll
        for (int k = 0; k < 4; ++k) rinv[k] = 32.f * __builtin_amdgcn_rcpf(li_l[crow(4 * rg + k, hi)]);
        unsigned char* orow = Ow + (long)(8 * rg + 4 * hi + qi) * 2048 + (r32 & ~3);
#pragma unroll
        for (int d0 = 0; d0 < 4; ++d0) {
            int w = 0;
            w = __builtin_amdgcn_cvt_pk_fp8_f32(o[d0][4 * rg] * rinv[0], o[d0][4 * rg + 1] * rinv[1], w, false);
            w = __builtin_amdgcn_cvt_pk_fp8_f32(o[d0][4 * rg + 2] * rinv[2], o[d0][4 * rg + 3] * rinv[3], w, true);
            const unsigned p1 = (unsigned)__builtin_amdgcn_update_dpp(0, w, 0xB1, 0xf, 0xf, true);
            const unsigned wa = __builtin_amdgcn_perm(p1, (unsigned)w, selA);
            const unsigned p2 = (unsigned)__builtin_amdgcn_update_dpp(0, (int)wa, 0x4E, 0xf, 0xf, true);
            *(unsigned*)(orow + d0 * 32) = __builtin_amdgcn_perm(p2, wa, selB);
        }
    }
    __syncthreads();
#undef SLOAD
#undef SWRITE
#undef RESC
#undef MASKT
#undef MLOAD
}
}
namespace idx {
using bf16 = unsigned short;
using bf16x8 = __attribute__((ext_vector_type(8))) short;
using f32x4 = __attribute__((ext_vector_type(4))) float;
using u32x4 = __attribute__((ext_vector_type(4))) unsigned;
using u32x2 = __attribute__((ext_vector_type(2))) unsigned;
constexpr int ROWW = 2052;
constexpr int LDS_BYTES = 16 * ROWW * 4;
#define IDX_LAS __attribute__((address_space(3)))

__device__ __forceinline__ float funkey(unsigned k) { return __uint_as_float((k & 0x80000000u) ? (k ^ 0x80000000u) : ~k); }
__device__ __forceinline__ unsigned fkey(float f) { const unsigned u = __float_as_uint(f + 0.0f); return u ^ ((unsigned)((int)u >> 31) | 0x80000000u); }
__device__ __forceinline__ void cnt_ge(unsigned& cnt, unsigned key, unsigned ref) { asm("v_cmp_ge_u32 vcc, %1, %2\n\tv_addc_co_u32 %0, vcc, 0, %0, vcc" : "+v"(cnt) : "v"(key), "v"(ref) : "vcc"); }
__device__ __forceinline__ void cnt_gt(unsigned& cnt, unsigned key, unsigned ref) { asm("v_cmp_gt_u32 vcc, %1, %2\n\tv_addc_co_u32 %0, vcc, 0, %0, vcc" : "+v"(cnt) : "v"(key), "v"(ref) : "vcc"); }
__device__ __forceinline__ void cnt_eq(unsigned& cnt, unsigned key, unsigned ref) { asm("v_cmp_eq_u32 vcc, %1, %2\n\tv_addc_co_u32 %0, vcc, 0, %0, vcc" : "+v"(cnt) : "v"(key), "v"(ref) : "vcc"); }
__device__ __forceinline__ void cnt_ge4(unsigned& c0, unsigned& c1, unsigned& c2, unsigned& c3, unsigned k0, unsigned k1, unsigned k2, unsigned k3, unsigned ref) {
    asm("v_cmp_ge_u32 s[70:71], %4, %8\n\tv_cmp_ge_u32 s[72:73], %5, %8\n\tv_cmp_ge_u32 s[74:75], %6, %8\n\tv_cmp_ge_u32 vcc, %7, %8\n\t"
        "v_addc_co_u32 %0, s[70:71], 0, %0, s[70:71]\n\tv_addc_co_u32 %1, s[72:73], 0, %1, s[72:73]\n\tv_addc_co_u32 %2, s[74:75], 0, %2, s[74:75]\n\tv_addc_co_u32 %3, vcc, 0, %3, vcc"
        : "+v"(c0), "+v"(c1), "+v"(c2), "+v"(c3) : "v"(k0), "v"(k1), "v"(k2), "v"(k3), "v"(ref) : "vcc", "s70", "s71", "s72", "s73", "s74", "s75");
}
#define IDX_DPP(v, ctrl) ((unsigned)__builtin_amdgcn_update_dpp(0, (int)(v), ctrl, 0xf, 0xf, true))
__device__ __forceinline__ unsigned half_sum(unsigned v) {
    v += IDX_DPP(v, 0xB1); v += IDX_DPP(v, 0x4E); v += IDX_DPP(v, 0x141); v += IDX_DPP(v, 0x140); { auto r = __builtin_amdgcn_permlane16_swap(v, v, false, false); v = r[0] + r[1]; } return v;
}
__device__ __forceinline__ unsigned half_min(unsigned v) {
    v = min(v, IDX_DPP(v, 0xB1)); v = min(v, IDX_DPP(v, 0x4E)); v = min(v, IDX_DPP(v, 0x141)); v = min(v, IDX_DPP(v, 0x140)); { auto r = __builtin_amdgcn_permlane16_swap(v, v, false, false); v = min(r[0], r[1]); } return v;
}
__device__ __forceinline__ unsigned half_max(unsigned v) {
    v = max(v, IDX_DPP(v, 0xB1)); v = max(v, IDX_DPP(v, 0x4E)); v = max(v, IDX_DPP(v, 0x141)); v = max(v, IDX_DPP(v, 0x140)); { auto r = __builtin_amdgcn_permlane16_swap(v, v, false, false); v = max(r[0], r[1]); } return v;
}

struct Conv { const float* wgu; const float* wdn; bf16* wgu_t; bf16* wdn_t; };
__device__ __forceinline__ unsigned f2bf_(float f) { const unsigned u = __float_as_uint(f); return (u + 0x7fffu + ((u >> 16) & 1u)) >> 16; }
struct ConvBuf { float v[8][8]; unsigned char* dst; };
__device__ __forceinline__ void conv_load(ConvBuf& B, const Conv& cv, int st, int lane) {
    const float* W; bf16* WT; int nsrc, srcc, nb, kb;
    if (st < 16384) { const int e = st >> 9, r = st & 511; kb = r >> 5; nb = r & 31; W = cv.wgu + (size_t)e * 1024 * 2048; WT = (bf16*)((unsigned char*)cv.wgu_t + (size_t)e * 2048 * 1024); nsrc = 2048;
        const int n = 64 * nb, pn = n >> 8, wth = n & 255; srcc = wth < 128 ? 128 * pn + wth : 1024 + 128 * pn + (wth - 128); }
    else { const int s2 = st - 16384, e = s2 >> 8, r = s2 & 255; kb = r >> 4; nb = r & 15; W = cv.wdn + (size_t)e * 1024 * 1024; WT = (bf16*)((unsigned char*)cv.wdn_t + (size_t)e * 1024 * 1024); nsrc = 1024; srcc = 64 * nb; }
    const float* src = W + (size_t)(64 * kb) * nsrc + srcc + lane;
    B.dst = (unsigned char*)WT + (size_t)(64 * nb + lane) * 1024 + 64 * kb;
#pragma unroll
    for (int s = 0; s < 8; ++s)
#pragma unroll
        for (int k = 0; k < 8; ++k) B.v[s][k] = src[(size_t)(8 * s + k) * nsrc];
}
__device__ __forceinline__ void conv_store(const ConvBuf& B) {
#pragma unroll
    for (int s = 0; s < 8; ++s) { int w0 = 0, w1 = 0;
        w0 = __builtin_amdgcn_cvt_pk_fp8_f32(B.v[s][0] * 64.f, B.v[s][1] * 64.f, w0, false); w0 = __builtin_amdgcn_cvt_pk_fp8_f32(B.v[s][2] * 64.f, B.v[s][3] * 64.f, w0, true);
        w1 = __builtin_amdgcn_cvt_pk_fp8_f32(B.v[s][4] * 64.f, B.v[s][5] * 64.f, w1, false); w1 = __builtin_amdgcn_cvt_pk_fp8_f32(B.v[s][6] * 64.f, B.v[s][7] * 64.f, w1, true);
        u32x2 o; o.x = (unsigned)w0; o.y = (unsigned)w1; *(u32x2*)(B.dst + 8 * s) = o; }
}
__device__ __forceinline__ void conv_super(const Conv& cv, int st, int lane) { ConvBuf B; conv_load(B, cv, st, lane); conv_store(B); }
struct ConvH { float v[4][8]; unsigned char* dst; };
__device__ __forceinline__ void conv_load_h(ConvH& B, const Conv& cv, int st, int hf, int lane) {
    const float* W; bf16* WT; int nsrc, srcc, nb, kb;
    if (st < 16384) { const int e = st >> 9, r = st & 511; kb = r >> 5; nb = r & 31; W = cv.wgu + (size_t)e * 1024 * 2048; WT = (bf16*)((unsigned char*)cv.wgu_t + (size_t)e * 2048 * 1024); nsrc = 2048;
        const int n = 64 * nb, pn = n >> 8, wth = n & 255; srcc = wth < 128 ? 128 * pn + wth : 1024 + 128 * pn + (wth - 128); }
    else { const int s2 = st - 16384, e = s2 >> 8, r = s2 & 255; kb = r >> 4; nb = r & 15; W = cv.wdn + (size_t)e * 1024 * 1024; WT = (bf16*)((unsigned char*)cv.wdn_t + (size_t)e * 1024 * 1024); nsrc = 1024; srcc = 64 * nb; }
    const float* src = W + (size_t)(64 * kb + 32 * hf) * nsrc + srcc + lane;
    B.dst = (unsigned char*)WT + (size_t)(64 * nb + lane) * 1024 + 64 * kb + 32 * hf;
#pragma unroll
    for (int s = 0; s < 4; ++s)
#pragma unroll
        for (int k = 0; k < 8; ++k) B.v[s][k] = src[(size_t)(8 * s + k) * nsrc];
}
__device__ __forceinline__ void conv_store_h(const ConvH& B) {
#pragma unroll
    for (int s = 0; s < 4; ++s) { int w0 = 0, w1 = 0;
        w0 = __builtin_amdgcn_cvt_pk_fp8_f32(B.v[s][0] * 64.f, B.v[s][1] * 64.f, w0, false); w0 = __builtin_amdgcn_cvt_pk_fp8_f32(B.v[s][2] * 64.f, B.v[s][3] * 64.f, w0, true);
        w1 = __builtin_amdgcn_cvt_pk_fp8_f32(B.v[s][4] * 64.f, B.v[s][5] * 64.f, w1, false); w1 = __builtin_amdgcn_cvt_pk_fp8_f32(B.v[s][6] * 64.f, B.v[s][7] * 64.f, w1, true);
        u32x2 o; o.x = (unsigned)w0; o.y = (unsigned)w1; *(u32x2*)(B.dst + 8 * s) = o; }
}
__device__ __forceinline__ void index_unit(const bf16* __restrict__ proj, const float* __restrict__ widx, unsigned* __restrict__ mask, int b, int qg, IDX_LAS unsigned char* lds,
                                           const Conv& cv, int tbase, int quota) {
    int tid_ = threadIdx.x; asm volatile("" : "+v"(tid_));
    const int tid = tid_, w = __builtin_amdgcn_readfirstlane(tid >> 6), lane = tid & 63;
    const int c = qg >> 2;
    ConvH H0, H1, H2;
#define CONV_ISSUE() do { if (quota) { conv_load_h(H0, cv, tbase + ((3 * w) >> 1), (3 * w) & 1, lane); conv_load_h(H1, cv, tbase + ((3 * w + 1) >> 1), (3 * w + 1) & 1, lane); \
                                        conv_load_h(H2, cv, tbase + ((3 * w + 2) >> 1), (3 * w + 2) & 1, lane); } } while (0)
#define CONV_RETIRE() do { if (quota) { conv_store_h(H0); conv_store_h(H1); conv_store_h(H2); } } while (0)
    IDX_LAS unsigned* kl = (IDX_LAS unsigned*)lds;
    const int j = lane & 31;
    if (c >= 4) {
        REPS(20) {
            const int q = lane & 15, g = lane >> 4;
            const size_t trow = (size_t)b * 2048 + 16 * qg + q;
            bf16x8 bq[8][2]; float wi[8];
            const bf16* qp = proj + trow * 6400 + 3840 + 8 * g;
#pragma unroll
            for (int h = 0; h < 8; ++h) { bq[h][0] = *reinterpret_cast<const bf16x8*>(qp + h * 64); bq[h][1] = *reinterpret_cast<const bf16x8*>(qp + h * 64 + 32); }
            { const f32x4 a0 = *(const f32x4*)(widx + trow * 8), a1 = *(const f32x4*)(widx + trow * 8 + 4);
              wi[0] = a0[0]; wi[1] = a0[1]; wi[2] = a0[2]; wi[3] = a0[3]; wi[4] = a1[0]; wi[5] = a1[1]; wi[6] = a1[2]; wi[7] = a1[3]; }
            bf16x8 ak[2][4][2];
            const bf16* kbase = proj + ((size_t)b * 2048 + q) * 6400 + 704 + 8 * g;
#define IDX_LOADK(buf, jj) do { _Pragma("unroll") for (int t = 0; t < 4; ++t) { const bf16* kp = kbase + (size_t)(64 * (jj) + 16 * t) * 6400; \
                ak[buf][t][0] = *reinterpret_cast<const bf16x8*>(kp); ak[buf][t][1] = *reinterpret_cast<const bf16x8*>(kp + 32); } } while (0)
            if (w <= c) IDX_LOADK(0, w);
#pragma unroll
            for (int s = 0; s < 4; ++s) {
                const int jt = w + 8 * s;
                __builtin_amdgcn_sched_barrier(0);
                if (s < 3) { if (jt + 8 <= c) IDX_LOADK((s + 1) & 1, jt + 8); }
                __builtin_amdgcn_sched_barrier(0);
                if (jt <= c) {
#pragma unroll
                    for (int t = 0; t < 4; ++t) {
                        f32x4 sc = {0.f, 0.f, 0.f, 0.f};
#pragma unroll
                        for (int h = 0; h < 8; ++h) {
                            f32x4 acc = {0.f, 0.f, 0.f, 0.f};
                            acc = __builtin_amdgcn_mfma_f32_16x16x32_bf16(ak[s & 1][t][0], bq[h][0], acc, 0, 0, 0);
                            acc = __builtin_amdgcn_mfma_f32_16x16x32_bf16(ak[s & 1][t][1], bq[h][1], acc, 0, 0, 0);
#pragma unroll
                            for (int r = 0; r < 4; ++r) sc[r] = fmaf(wi[h], __int_as_float(max(__float_as_int(acc[r]), 0)), sc[r]);
                        }
                        u32x4 kv; kv.x = fkey(sc[0]); kv.y = fkey(sc[1]); kv.z = fkey(sc[2]); kv.w = fkey(sc[3]);
                        *(IDX_LAS u32x4*)(kl + q * ROWW + 64 * jt + 4 * (4 * t + g)) = kv;
                    }
                }
            }
#undef IDX_LOADK
        }
        __syncthreads();
        CONV_ISSUE();
        {
            const int qq = 2 * w + (lane >> 5); unsigned w0, w1;
            const int nkeys = 64 * (c + 1), nch = (nkeys + 127) >> 7;
            unsigned key[16][4];
#pragma unroll
            for (int i = 0; i < 16; ++i) {
                u32x4 kv = {0u, 0u, 0u, 0u};
                if (i < nch) { if (128 * i + 4 * j < nkeys) kv = *(const IDX_LAS u32x4*)(kl + qq * ROWW + 128 * i + 4 * j); }
                key[i][0] = kv.x; key[i][1] = kv.y; key[i][2] = kv.z; key[i][3] = kv.w;
            }
            unsigned kmin = 0xffffffffu, kmax = 0u;
#pragma unroll
            for (int i = 0; i < 16; ++i)
                if (i < nch) {
                    const bool ok = 128 * i + 4 * j < nkeys;
#pragma unroll
                    for (int r = 0; r < 4; ++r) { kmin = min(kmin, ok ? key[i][r] : 0xffffffffu); kmax = max(kmax, key[i][r]); }
                }
            kmin = half_min(kmin); kmax = half_max(kmax);
            unsigned lo = kmin, hi = kmax + 1u;
            float flo = (float)(nkeys - 256), fhi = -256.f;
            unsigned clo = (unsigned)nkeys, chi = 0u;
            int side = 0; bool done = false;
#pragma unroll 1
            for (int it = 0; ; ++it) {
                unsigned cand;
                if (hi - lo <= 1u) { done = true; cand = lo; }
                else if (it >= 24) cand = lo + ((hi - lo) >> 1);
                else {
                    const float vlo = funkey(lo), vhi = funkey(hi - 1u);
                    const float fr = (flo - fhi <= 6.f && (it & 1)) ? 0.5f : flo * __builtin_amdgcn_rcpf(flo - fhi);
                    cand = fkey(vlo + (vhi - vlo) * fr);
                    cand = cand <= lo ? lo + 1u : cand; cand = cand >= hi ? hi - 1u : cand;
                }
                if (__all(done)) break;
                unsigned c0 = 0, c1 = 0, c2 = 0, c3 = 0;
#pragma unroll
                for (int i = 0; i < 16; i += 2) if (i < nch) { cnt_ge4(c0, c1, c2, c3, key[i][0], key[i][1], key[i][2], key[i][3], cand);
                                                               cnt_ge4(c0, c1, c2, c3, key[i + 1][0], key[i + 1][1], key[i + 1][2], key[i + 1][3], cand); }
                const unsigned tot = half_sum((c0 + c1) + (c2 + c3));
                if (!done) {
                    const float f = (float)((int)tot - 256);
                    if (tot >= 256u) { lo = cand; flo = f; clo = tot; if (side == 1) fhi *= 0.5f; side = 1; }
                    else             { hi = cand; fhi = f; chi = tot; if (side == 2) flo *= 0.5f; side = 2; }
                    if (tot == 256u) done = true;
                }
            }
            const unsigned T = lo;
            const int need = (clo == 256u) ? 0x7fffffff : 256 - (int)chi;
            const bool tie = __any(clo > 256u);
            IDX_LAS unsigned* mw = (IDX_LAS unsigned*)(lds + LDS_BYTES) + qq * 64;
            *(IDX_LAS u32x2*)(mw + 2 * j) = (u32x2){0u, 0u};
            const int hi_ = j & 1, sh_ = 16 * ((j >> 3) & 1) + 4 * ((j >> 1) & 3);
            int base = 0;
#pragma unroll
            for (int i = 0; i < 16; ++i)
                if (i < nch) {
                    unsigned nib = 0;
                    if (!tie) {
#pragma unroll
                        for (int r = 0; r < 4; ++r) nib |= (key[i][r] >= T) ? (1u << r) : 0u;
                    } else {
                        int e = 0;
#pragma unroll
                        for (int r = 0; r < 4; ++r) e += (key[i][r] == T) ? 1 : 0;
                        int incl = e;
#pragma unroll
                        for (int d = 1; d < 32; d <<= 1) { const int t = __shfl_up(incl, d, 32); if (j >= d) incl += t; }
                        int run = base + incl - e;
                        base += __shfl(incl, 31, 32);
#pragma unroll
                        for (int r = 0; r < 4; ++r) { const unsigned k = key[i][r]; const bool eq = (k == T); const bool sel = (k > T) || (eq && run < need); run += eq ? 1 : 0; nib |= sel ? (1u << r) : 0u; }
                    }
                    if (nib) (void)__hip_atomic_fetch_or(mw + (2 * i + (j >> 4)) * 2 + hi_, nib << sh_, __ATOMIC_RELAXED, __HIP_MEMORY_SCOPE_WORKGROUP);
                }
            asm volatile("s_waitcnt lgkmcnt(0)" ::: "memory");
            { const u32x2 o = *(const IDX_LAS u32x2*)(mw + 2 * j); w0 = o.x; w1 = o.y; }
            { u32x2 o; o.x = w0; o.y = w1; *(u32x2*)(mask + (((size_t)b * 2048 + 16 * qg + qq) * 32 + j) * 2) = o; }
        }
        CONV_RETIRE();
    } else {
        __syncthreads();
        CONV_ISSUE();
        {
            const int qq = 2 * w + (lane >> 5);
            u32x2 o; o.x = j <= c ? 0xffffffffu : 0u; o.y = o.x; *(u32x2*)(mask + (((size_t)b * 2048 + 16 * qg + qq) * 32 + j) * 2) = o;
        }
        CONV_RETIRE();
    }
    __syncthreads();
#undef CONV_ISSUE
#undef CONV_RETIRE
}
}
constexpr int NWAVES = 8;
constexpr int T = 32768, SEQ = 2048, NB = 16, DM = 1024, PP = 6400;
constexpr size_t MiB = 1u << 20;
constexpr size_t WS_CTL = 0, CTL_ZERO_BYTES = 64 * 1024;
constexpr size_t WS_WIDX = 1 * MiB;
constexpr size_t WS_SSQ  = 2 * MiB;
constexpr size_t WS_PICK = 5 * MiB;
constexpr size_t WS_WRH  = 5 * MiB + 512 * 1024;
constexpr size_t WS_MASK = 6 * MiB;
constexpr size_t WS_TOK  = 14 * MiB;
constexpr size_t WS_GATE = 18 * MiB;
constexpr size_t WS_WIN  = 22 * MiB;
constexpr size_t WS_WUQ  = WS_WIN + (size_t)6400 * 1024 * 2;
constexpr size_t WS_WUK  = WS_WUQ + (size_t)1536 * 384 * 2;
constexpr size_t WS_WUV  = WS_WUK + (size_t)1024 * 256 * 2;
constexpr size_t WS_WOA  = WS_WUV + (size_t)1024 * 256 * 2;
constexpr size_t WS_WOB  = WS_WOA + (size_t)1024 * 1024 * 2;
constexpr size_t WS_WOUT = WS_WOB + (size_t)1024 * 1024 * 2;
constexpr size_t WS_WGU  = 44 * MiB;
constexpr size_t WS_W8   = 108 * MiB;
constexpr size_t WS_WIN8 = WS_W8, WS_WOA8 = WS_W8 + 7 * MiB, WS_WOB8 = WS_W8 + 8 * MiB, WS_WOUT8 = WS_W8 + 9 * MiB, WS_WUQ8 = WS_W8 + 10 * MiB, WS_WUK8 = WS_W8 + 11 * MiB, WS_WUV8 = WS_WUK8 + 512 * 1024;
constexpr size_t WS_WDN  = 172 * MiB;
constexpr size_t WS_RA   = 236 * MiB;
constexpr size_t WS_RB   = 364 * MiB;
constexpr size_t WS_RC   = 764 * MiB;
constexpr size_t WS_END  = 1020 * MiB;
static_assert(WS_WOUT + (size_t)1024 * 1024 * 2 <= WS_WGU, "ws map");
constexpr size_t RC_Q = 0, RC_K = (size_t)T * 1536 * 2, RC_V = RC_K + (size_t)T * 1024 * 2;
constexpr size_t RC_MA = 0, RC_MG = (size_t)T * 1024 * 2;
constexpr int CW_BAR = 1024;
constexpr int CW_CNT = 8192;
constexpr int RING_BYTES = 131072, LDSCTL_OFF = 139264, MISC_OFF = LDSCTL_OFF + 320, TAB_OFF = LDSCTL_OFF + 1024  , LDS_BYTES = 147456;

#define GAS __attribute__((address_space(1)))
#define LAS __attribute__((address_space(3)))
typedef unsigned short bf16;
typedef unsigned v4u __attribute__((ext_vector_type(4)));
typedef unsigned v2u __attribute__((ext_vector_type(2)));
typedef float f32x4 __attribute__((ext_vector_type(4)));
#define LDS_WAIT() asm volatile("s_waitcnt lgkmcnt(0)" ::: "memory")
#define VM_WAIT() asm volatile("s_waitcnt vmcnt(0)" ::: "memory")
__device__ __forceinline__ unsigned f2bf(float f) { unsigned u = __builtin_bit_cast(unsigned, f); return (u + 0x7fffu + ((u >> 16) & 1u)) >> 16; }
__device__ __forceinline__ unsigned pk2(float lo, float hi) { return f2bf(lo) | (f2bf(hi) << 16); }

#define XB_TMO      128
#define XB_XCNT(j)  (256  + 64 * (j))
#define XB_XSUB(j)  (1280 + 64 * (j))
#define XB_XGEN(j)  (2304 + 64 * (j))
#define XB_TOP      3328
#define XB_TOPGEN   3392
#define XCD_BAR_WORDS 3456
#define XB_SPIN_CAP (1u << 25)
__device__ __forceinline__ unsigned xb_ld(unsigned* p)              { return __hip_atomic_load(p, __ATOMIC_RELAXED, __HIP_MEMORY_SCOPE_AGENT); }
__device__ __forceinline__ unsigned xb_add(unsigned* p, unsigned v) { return __hip_atomic_fetch_add(p, v, __ATOMIC_RELAXED, __HIP_MEMORY_SCOPE_AGENT); }
__device__ __forceinline__ unsigned xb_xcc_id() { return (unsigned)__builtin_amdgcn_s_getreg((3 << 11) | 20) & 0xFu; }
#define XB_SPIN(cond, bar) do { unsigned _sp = 0; while (cond) { __builtin_amdgcn_s_sleep(1); \
    if ((++_sp & 255u) == 0u) { if (xb_ld(&(bar)[XB_TMO])) break; if (_sp > XB_SPIN_CAP) { atomicAdd(&(bar)[XB_TMO], 1u); break; } } } } while (0)
struct XcdBarrier { unsigned* bar; unsigned x; volatile LAS unsigned* st; };
__device__ __forceinline__ XcdBarrier xcd_barrier_post(unsigned* bar, volatile LAS unsigned* st) {
    XcdBarrier b; b.bar = bar; b.x = xb_xcc_id(); b.st = st;
    if (threadIdx.x == 0) (void)xb_add(&bar[XB_XCNT(b.x)], 1u);
    return b;
}
__device__ __forceinline__ void xcd_barrier_complete(unsigned* bar, unsigned x, unsigned& nloc, unsigned& nx) {
    const unsigned G = gridDim.x * gridDim.y * gridDim.z;
    unsigned sum, cnt, mine, sp = 0u;
    for (;;) {
        sum = 0u; cnt = 0u; mine = 0u;
#pragma unroll
        for (unsigned j = 0; j < 16; ++j) { const unsigned c = xb_ld(&bar[XB_XCNT(j)]); sum += c; cnt += (c > 0u) ? 1u : 0u; mine = (j == x) ? c : mine; }
        if (sum == G) break;
        __builtin_amdgcn_s_sleep(1);
        if ((++sp & 255u) == 0u) { if (xb_ld(&bar[XB_TMO])) break; if (sp > XB_SPIN_CAP) { atomicAdd(&bar[XB_TMO], 1u); break; } }
    }
    nloc = mine > 0u ? mine : 1u; nx = cnt > 0u ? cnt : 1u;
}
__device__ __forceinline__ void xcd_barrier(const XcdBarrier& b) {
    asm volatile("s_waitcnt vmcnt(0)" ::: "memory");
    __syncthreads();
    if (threadIdx.x == 0) {
        unsigned* bar = b.bar;
        __builtin_amdgcn_s_waitcnt(0);
        unsigned nloc = b.st[0], nx = b.st[1];
        if (nloc == 0u) { xcd_barrier_complete(bar, b.x, nloc, nx); b.st[0] = nloc; b.st[1] = nx; }
        const unsigned old = xb_add(&bar[XB_XSUB(b.x)], 1u);
        const unsigned gen = old / nloc;
        if (old + 1u == (gen + 1u) * nloc) {
            __builtin_amdgcn_fence(__ATOMIC_RELEASE, "agent");
            asm volatile("s_waitcnt vmcnt(0)" ::: "memory");
            const unsigned og = xb_add(&bar[XB_TOP], 1u);
            const unsigned tg = og / nx;
            if (og + 1u == (tg + 1u) * nx) xb_add(&bar[XB_TOPGEN], 1u);
            else XB_SPIN(xb_ld(&bar[XB_TOPGEN]) == tg, bar);
            __builtin_amdgcn_fence(__ATOMIC_ACQUIRE, "agent");
            xb_add(&bar[XB_XGEN(b.x)], 1u);
            asm volatile("s_waitcnt vmcnt(0)" ::: "memory");
        } else {
            XB_SPIN(xb_ld(&bar[XB_XGEN(b.x)]) == gen, bar);
            __builtin_amdgcn_fence(__ATOMIC_ACQUIRE, "agent");
            asm volatile("s_waitcnt vmcnt(0)" ::: "memory");
        }
    }
    __syncthreads();
}

__device__ __forceinline__ float wave_sum(float v) {
#pragma unroll
    for (int o = 1; o < 64; o <<= 1) v += __shfl_xor(v, o);
    return v;
}

struct MapIn {
    static constexpr bool VEC2 = false;
    __device__ __forceinline__ static int src(int n) {
        if (n < 640) return n;
        if (n < 704) { const int j = n - 640; return 640 + ((j & 1) ? 32 + (j >> 1) : (j >> 1)); }
        if (n < 768) { const int j = n - 704; return 4288 + (j < 32 ? ((j & 1) ? 16 + (j >> 1) : (j >> 1)) : j); }
        if (n < 3840) { const int j = n - 768, part = j >> 10, hh = (j & 1023) >> 7, d = j & 127; const int base = 704 + part * 1024 + hh * 128;
            return base + (part < 2 ? ((d & 1) ? 64 + (d >> 1) : (d >> 1)) : d); }
        if (n < 4352) { const int j = n - 3840, hh = j >> 6, d = j & 63; return 3776 + hh * 64 + (d < 32 ? ((d & 1) ? 16 + (d >> 1) : (d >> 1)) : d); }
        return 4360 + (n - 4352);
    }
};
struct MapUq { static constexpr bool VEC2 = false; __device__ __forceinline__ static int src(int n) { const int hh = n / 192, d = n - hh * 192; if (d < 128) return n; const int j = d - 128; return hh * 192 + 128 + ((j & 1) ? 32 + (j >> 1) : (j >> 1)); } };
struct MapId { static constexpr bool VEC2 = true; __device__ __forceinline__ static int src(int n) { return n; } };
struct MapGu { static constexpr bool VEC2 = true; __device__ __forceinline__ static int src(int n) { const int pn = n >> 8, wth = n & 255; return wth < 128 ? 128 * pn + wth : 1024 + 128 * pn + (wth - 128); } };
template <class Map>
__device__ __forceinline__ void p0_transpose_item(const float* W, int K, int Nsrc, int nblk, bf16* WT, const float* kscale, LAS float* scr, int item, int lane, unsigned char* WT8 = nullptr, int K8 = 0) {
    const int kb = item / nblk, nb = item - kb * nblk, k0 = 64 * kb, n0 = 64 * nb;
    if constexpr (Map::VEC2) {
        const int sc = Map::src(n0 + 2 * (lane & 31)), hk = lane >> 5;
        typedef float f32x2_ __attribute__((ext_vector_type(2)));
        f32x2_ v[32];
#pragma unroll
        for (int i = 0; i < 32; ++i) v[i] = *(const GAS f32x2_*)(W + (size_t)(k0 + 2 * i + hk) * Nsrc + sc);
#pragma unroll
        for (int i = 0; i < 32; ++i) { const int kk = 2 * i + hk; float sc_ = kscale ? kscale[k0 + kk] : 1.f; scr[kk * 65 + 2 * (lane & 31)] = v[i].x * sc_; scr[kk * 65 + 2 * (lane & 31) + 1] = v[i].y * sc_; }
    } else {
    const int sc = Map::src(n0 + lane);
    float vv[64];
#pragma unroll
    for (int i = 0; i < 64; ++i) vv[i] = W[(size_t)(k0 + i) * Nsrc + sc];
#pragma unroll
    for (int i = 0; i < 64; ++i) { float v = vv[i]; if (kscale) v *= kscale[k0 + i]; scr[i * 65 + lane] = v; }
    }
    LDS_WAIT(); asm volatile("" ::: "memory");
    const int c = lane & 7;
#pragma unroll
    for (int j = 0; j < 8; ++j) { const int n = (lane >> 3) + 8 * j; const LAS float* s = scr + (8 * c) * 65 + n;
        if (WT) { v4u o; o.x = pk2(s[0 * 65], s[1 * 65]); o.y = pk2(s[2 * 65], s[3 * 65]); o.z = pk2(s[4 * 65], s[5 * 65]); o.w = pk2(s[6 * 65], s[7 * 65]);
            *(GAS v4u*)(WT + (size_t)(n0 + n) * K + k0 + 8 * c) = o; }
        if (WT8) { int w0 = 0, w1 = 0;
            w0 = __builtin_amdgcn_cvt_pk_fp8_f32(s[0 * 65] * 64.f, s[1 * 65] * 64.f, w0, false); w0 = __builtin_amdgcn_cvt_pk_fp8_f32(s[2 * 65] * 64.f, s[3 * 65] * 64.f, w0, true);
            w1 = __builtin_amdgcn_cvt_pk_fp8_f32(s[4 * 65] * 64.f, s[5 * 65] * 64.f, w1, false); w1 = __builtin_amdgcn_cvt_pk_fp8_f32(s[6 * 65] * 64.f, s[7 * 65] * 64.f, w1, true);
            v2u o8; o8.x = (unsigned)w0; o8.y = (unsigned)w1; *(GAS v2u*)(WT8 + (size_t)(n0 + n) * K8 + k0 + 8 * c) = o8; } }
    LDS_WAIT(); asm volatile("" ::: "memory");
}

#ifndef P1_BF16_TILES
#define P1_BF16_TILES 0u
#endif
#ifndef PHASE_MASK
#define PHASE_MASK 0xFFFF
#endif
struct Args { const float* in[20]; float* out; unsigned char* ws; };

__global__ void __launch_bounds__(NWAVES * 64, 2) fwd_megakernel(Args args) {
    extern __shared__ __attribute__((aligned(16))) unsigned char lds[];
    LAS unsigned char* ldsl = (LAS unsigned char*)lds;
    volatile LAS unsigned* MISC = (volatile LAS unsigned*)(ldsl + MISC_OFF);
#define PHASE_IDS int tid_ = threadIdx.x; asm volatile("" : "+v"(tid_)); const int tid = tid_, lane = tid & 63, wave = __builtin_amdgcn_readfirstlane(tid >> 6); const int gw = vcu * NWAVES + wave, NGW = G * NWAVES; (void)lane; (void)gw; (void)NGW;
    const int G = gridDim.x, bx = blockIdx.x;
    const int vcu = (G % 8 == 0) ? (bx % 8) * (G / 8) + bx / 8 : bx;
    unsigned char* ws = args.ws;
    unsigned* ctl = (unsigned*)(ws + WS_CTL);
    const float* x = args.in[0]; const float* norm_attn_g = args.in[1]; const float* w_in = args.in[2]; const float* q_lora_g = args.in[3]; const float* kv_lora_g = args.in[4];
    const float* w_uq = args.in[5]; const float* w_uk = args.in[6]; const float* w_uv = args.in[7]; const float* w_o_mla = args.in[8]; const float* w_o_dsa = args.in[9];
    const float* b_gate = args.in[10]; const float* w_out = args.in[11]; const float* norm_ffn_g = args.in[12]; const float* w_router = args.in[13]; const float* b_router = args.in[14];
    const float* w_gate_up = args.in[15]; const float* b_gate_up = args.in[16]; const float* w_down = args.in[17]; const float* b_down = args.in[18]; const float* norm_final_g = args.in[19];
    float* out = args.out;
    float* widx = (float*)(ws + WS_WIDX); float* ssq = (float*)(ws + WS_SSQ); int* pick = (int*)(ws + WS_PICK); unsigned* mask = (unsigned*)(ws + WS_MASK);
    int* tokl = (int*)(ws + WS_TOK); float* gatek = (float*)(ws + WS_MASK);
    bf16* wrh = (bf16*)(ws + WS_WRH);
    bf16* win_t = (bf16*)(ws + WS_WIN); bf16* wuq_t = (bf16*)(ws + WS_WUQ); bf16* wuk_t = (bf16*)(ws + WS_WUK); bf16* wuv_t = (bf16*)(ws + WS_WUV);
    bf16* woa_t = (bf16*)(ws + WS_WOA); bf16* wob_t = (bf16*)(ws + WS_WOB); bf16* wout_t = (bf16*)(ws + WS_WOUT); bf16* wgu_t = (bf16*)(ws + WS_WGU); bf16* wdn_t = (bf16*)(ws + WS_WDN);
    bf16* hbuf = (bf16*)(ws + WS_RA); unsigned char* h8 = ws + WS_RA + 64 * MiB; unsigned char* win8 = ws + WS_WIN8;
    unsigned char* attn_out = ws + WS_RA; bf16* hn = (bf16*)(ws + WS_RA);
    bf16* x1b = (bf16*)(ws + WS_RA + 64 * MiB);
    unsigned char* woa8 = ws + WS_WOA8; unsigned char* wob8 = ws + WS_WOB8; unsigned char* wout8 = ws + WS_WOUT8; unsigned char* merged8 = ws + WS_RC + RC_MG;
    unsigned char* wuq8 = ws + WS_WUQ8; unsigned char* wuk8 = ws + WS_WUK8; unsigned char* wuv8 = ws + WS_WUV8; unsigned char* lat8 = ws + WS_RA + 96 * MiB;
    bf16* proj = (bf16*)(ws + WS_RB); bf16* act = (bf16*)(ws + WS_RB);
    bf16* mla_q = (bf16*)(ws + WS_RC + RC_Q); bf16* mla_k = (bf16*)(ws + WS_RC + RC_K); bf16* mla_v = (bf16*)(ws + WS_RC + RC_V);
    bf16* merged_a = (bf16*)(ws + WS_RC + RC_MA); bf16* merged = (bf16*)(ws + WS_RC + RC_MG); bf16* ybuf = (bf16*)(ws + WS_RC);
    unsigned* gcnt = ctl + CW_CNT;

    for (int u = threadIdx.x; u < (LDS_BYTES - LDSCTL_OFF) / 4; u += NWAVES * 64) ((LAS unsigned*)(ldsl + LDSCTL_OFF))[u] = 0u;
    __syncthreads();
    XcdBarrier bar = xcd_barrier_post(ctl + CW_BAR, MISC + 8);
#define GRID_BAR() xcd_barrier(bar)
    LAS int* cum = (LAS int*)(ldsl + TAB_OFF); LAS int* cntt = cum + 33; LAS int* offt = cntt + 32;

#if PHASE_MASK & (1 << 0)
    {
        PHASE_IDS
        LAS float* scr = (LAS float*)(ldsl + wave * 16640);
        constexpr int I_IN = 16 * 100, I_UQ = 6 * 24, I_UK = 4 * 16, I_UV = 4 * 16, I_O = 16 * 16, I_GU = 16 * 32, I_DN = 16 * 16;
        constexpr int NITEMS = I_IN + I_UQ + I_UK + I_UV + 3 * I_O;
        REPS(0) for (int it = gw; it < NITEMS; it += NGW) {
            int r = it;
            if (r < I_IN) { p0_transpose_item<MapIn>(w_in, 1024, 6408, 100, P1_BF16_TILES ? win_t : nullptr, nullptr, scr, r, lane, win8, 1024); continue; } r -= I_IN;
            if (r < I_UQ) { p0_transpose_item<MapUq>(w_uq, 384, 1536, 24, nullptr, q_lora_g, scr, r, lane, wuq8, 512); continue; } r -= I_UQ;
            if (r < I_UK) { p0_transpose_item<MapId>(w_uk, 256, 1024, 16, nullptr, kv_lora_g, scr, r, lane, wuk8, 256); continue; } r -= I_UK;
            if (r < I_UV) { p0_transpose_item<MapId>(w_uv, 256, 1024, 16, nullptr, kv_lora_g, scr, r, lane, wuv8, 256); continue; } r -= I_UV;
            if (r < I_O) { p0_transpose_item<MapId>(w_o_mla, 1024, 1024, 16, nullptr, nullptr, scr, r, lane, woa8, 1024); continue; } r -= I_O;
            if (r < I_O) { p0_transpose_item<MapId>(w_o_dsa, 1024, 1024, 16, nullptr, nullptr, scr, r, lane, wob8, 1024); continue; } r -= I_O;
            p0_transpose_item<MapId>(w_out, 1024, 1024, 16, nullptr, nullptr, scr, r, lane, wout8, 1024);
        }
        __syncthreads();
        for (int idx = (int)blockIdx.x * (NWAVES * 64) + tid; idx < 1536 * 8; idx += G * NWAVES * 64) *(GAS v4u*)(wuq8 + (size_t)(idx >> 3) * 512 + 384 + 16 * (idx & 7)) = (v4u){0u, 0u, 0u, 0u};
        for (int idx = (int)blockIdx.x * (NWAVES * 64) + tid; idx < 32 * 1024; idx += G * NWAVES * 64) { const int e = idx >> 10, k = idx & 1023;
            const float xw = w_router[(size_t)k * 32 + e]; const unsigned hb = f2bf(xw); const float lw = xw - __uint_as_float(hb << 16);
            wrh[idx] = (bf16)hb; wrh[32 * 1024 + idx] = (bf16)f2bf(lw); }
        LAS float* wx = (LAS float*)ldsl;
        for (int i = tid; i < 8 * 1024; i += NWAVES * 64) { const int k = i >> 3, hh = i & 7; wx[hh * 1024 + k] = w_in[(size_t)k * 6408 + 4352 + hh]; }
        __syncthreads();
        REPS(10) for (int m = gw; m < T; m += NGW) {
            const GAS f32x4* xr = (const GAS f32x4*)(x + (size_t)m * DM) + lane;
            f32x4 v[4]; float s = 0.f;
#pragma unroll
            for (int j = 0; j < 4; ++j) { v[j] = xr[64 * j]; s += (v[j].x * v[j].x + v[j].y * v[j].y) + (v[j].z * v[j].z + v[j].w * v[j].w); }
            const float rstd = __builtin_amdgcn_rsqf(wave_sum(s) * (1.f / DM) + 1e-6f);
            GAS v2u* o8 = (GAS v2u*)(hbuf + (size_t)m * DM) + lane; GAS unsigned* o4 = (GAS unsigned*)(h8 + (size_t)m * DM) + lane;
#pragma unroll
            for (int j = 0; j < 4; ++j) { const f32x4 gg = *((const GAS f32x4*)norm_attn_g + lane + 64 * j); v[j] = v[j] * rstd * gg;
                if (P1_BF16_TILES) { v2u o; o.x = pk2(v[j].x, v[j].y); o.y = pk2(v[j].z, v[j].w); o8[64 * j] = o; }
                int w8 = 0; w8 = __builtin_amdgcn_cvt_pk_fp8_f32(v[j].x * 16.f, v[j].y * 16.f, w8, false); w8 = __builtin_amdgcn_cvt_pk_fp8_f32(v[j].z * 16.f, v[j].w * 16.f, w8, true); o4[64 * j] = (unsigned)w8; }
            float mine = 0.f;
#pragma unroll
            for (int hh = 0; hh < 8; ++hh) { float d = 0.f;
#pragma unroll
                for (int j = 0; j < 4; ++j) { const f32x4 wv = *((const LAS f32x4*)(wx + hh * 1024) + lane + 64 * j); d += (v[j].x * wv.x + v[j].y * wv.y) + (v[j].z * wv.z + v[j].w * wv.w); }
                d = wave_sum(d); if (lane == hh) mine = d; }
            if (lane < 8) widx[(size_t)m * 8 + lane] = mine * 0.35355339059327373f;
        }
        __syncthreads();
    }
    GRID_BAR();

#endif
#if PHASE_MASK & (1 << 1)
#ifdef PROBE_XBAR
    for (int xb_ = 0; xb_ < PROBE_XBAR; ++xb_) GRID_BAR();
#endif
    REPS(1) {
        constexpr unsigned P1_BF16 = P1_BF16_TILES, P1_ALL = (1u << 25) - 1u;
        pg8::EpiProj E{proj, b_gate, ssq, lat8};
        if (P1_BF16) { pg8::DenseOrder S; S.init(hbuf, 1024, win_t, 1024, T, 6400, G, bx, 2, P1_BF16);
          pg8::gemm_phase<pg8::EpiProj, pg8::DenseOrder, false>(ldsl, 1024, 1024, S, E, rep_ > 0); }
        { pg8::DenseOrder S; S.init(h8, 1024, win8, 1024, T, 6400, G, bx, 1, P1_ALL & ~P1_BF16, true);
          pg8::gemm_phase<pg8::EpiProj, pg8::DenseOrder, true, true>(ldsl, 1024, 1024, S, E, rep_ > 0, 0x79797979, 0x7b7b7b7b); }
    }
    GRID_BAR();

#endif
#if PHASE_MASK & (1 << 2)
    for (int ord_ = 0; ord_ < 2; ++ord_) {
        if (((ord_ ^ bx) & 1) == 0) REPS(2) {
        { pg8::DenseOrder S; S.init(lat8, 640, wuq8, 512, T, 1536, G, bx, 1, 0u, true); pg8::EpiMla E{mla_q, 1536, ssq, 0, 12, 1.f / 384.f, 1};
          pg8::gemm_phase<pg8::EpiMla, pg8::DenseOrder, true, true>(ldsl, 512, 640, S, E, false, 0x79797979, 0x7b7b7b7b); }
        { pg8::DenseOrder S; S.init(lat8 + 384, 640, wuk8, 256, T, 1024, G, bx, 1, 0u, true); pg8::EpiMla E{mla_k, 1024, ssq, 12, 8, 1.f / 256.f, 0};
          pg8::gemm_phase<pg8::EpiMla, pg8::DenseOrder, true, true>(ldsl, 256, 640, S, E, false, 0x79797979, 0x7b7b7b7b); }
        { pg8::DenseOrder S; S.init(lat8 + 384, 640, wuv8, 256, T, 1024, G, bx, 1, 0u, true); pg8::EpiMla E{mla_v, 1024, ssq, 12, 8, 1.f / 256.f, 0};
          pg8::gemm_phase<pg8::EpiMla, pg8::DenseOrder, true, true>(ldsl, 256, 640, S, E, false, 0x79797979, 0x7b7b7b7b); }
        __syncthreads(); }
        else REPS(12) {
            const idx::Conv cv{w_gate_up, w_down, wgu_t, wdn_t};
            int tdone = 0;
            for (int i = 0; ; ++i) { const int u = i * G + bx; if (u >= 2048) break;
                const int b = u >> 7, qraw = u & 127, qg = (i & 1) ? 127 - qraw : qraw;
                const int quota = (G == 256) ? min(12, 96 - tdone) : 0;
                idx::index_unit(proj, widx, mask, b, qg, ldsl, cv, vcu * 96 + tdone, quota); tdone += quota; }
            { const int w8 = __builtin_amdgcn_readfirstlane((int)threadIdx.x >> 6);
              if (G == 256) { for (int t = tdone + w8; t < 96; t += NWAVES) idx::conv_super(cv, vcu * 96 + t, (int)threadIdx.x & 63); }
              else { for (int st = vcu * NWAVES + w8; st < 24576; st += G * NWAVES) idx::conv_super(cv, st, (int)threadIdx.x & 63); } }
        }
    }
    GRID_BAR();

#endif
#if PHASE_MASK & (1 << 3)
    {
        for (int pass = 0; pass < 2; ++pass) REPS(3 + 10 * pass)
            for (int r = 0; ; ++r) {
                const int slot = r * G + ((r & 1) ? (G - 1 - bx) : bx); if (slot >= 1024) break;
                const int qb = 7 - (slot >> 7), bh = slot & 127, b = bh >> 3, h = bh & 7, i0 = qb * 256;
                const size_t row0 = (size_t)b * SEQ;
                if (pass == 0) REPS(33) {
#if !defined(ATT_ONLY) || ATT_ONLY == 0
                    att::attn_unit<0, 1536, 1024>(mla_q + (row0 + i0) * 1536 + h * 192, mla_k + row0 * 1024 + h * 128, mla_v + row0 * 1024 + h * 128, proj + row0 * PP + 640, nullptr,
                                                  attn_out + (row0 + i0) * 2048 + h * 128, i0, (char*)lds);
#endif
                } else REPS(34) {
#if !defined(ATT_ONLY) || ATT_ONLY == 1
                    att::attn_unit<1, PP, PP>(proj + (row0 + i0) * PP + 768 + h * 128, proj + row0 * PP + 1792 + h * 128, proj + row0 * PP + 2816 + h * 128, nullptr, mask + (row0 + i0) * 64,
                                              attn_out + (row0 + i0) * 2048 + 1024 + h * 128, i0, (char*)lds);
#endif
                }
            }
    }
    GRID_BAR();

#endif
#if PHASE_MASK & (1 << 4)
    REPS(4) {
        { pg8::DenseOrder S; S.init(attn_out, 2048, woa8, 1024, T, 1024, G, bx, 1, 0u, true); S.A2 = (const char*)(attn_out + 1024); S.B2 = (const char*)wob8;
          pg8::EpiGate2 E{(const unsigned char*)proj + 8704, merged8};
          pg8::gemm_phase<pg8::EpiGate2, pg8::DenseOrder, true, true, true>(ldsl, 1024, 2048, S, E, false, 0x79797979, 0x7a7a7a7a); }
    }
    GRID_BAR();

#endif
#if PHASE_MASK & (1 << 5)
    REPS(5) {
        pg8::DenseOrder S; S.init(merged8, 1024, wout8, 1024, T, 1024, G, bx, 1, 0u, true); pg8::EpiX1 E{x, x1b, ssq};
        pg8::gemm_phase<pg8::EpiX1, pg8::DenseOrder, true, true>(ldsl, 1024, 1024, S, E, false, 0x79797979, 0x79797979);
    }
    GRID_BAR();

#endif
#if PHASE_MASK & (1 << 6)
    {
        PHASE_IDS
        LAS unsigned* cntl = (LAS unsigned*)(ldsl + 120 * 1024); LAS unsigned* basel = cntl + 32;
        LAS unsigned char* hnl = ldsl + wave * (2 * 16 * 272); LAS float* lgl = (LAS float*)(ldsl + 80 * 1024 + wave * (16 * 32 * 4));
        typedef short bf16x8_ __attribute__((ext_vector_type(8)));
        const int q = lane & 15, g = lane >> 4;
        REPS(6) for (int grp = bx; grp < T / 128; grp += G) {
            const bool fx_ = (REPEAT_PHASE != 6) || rep_ == 1;
            if (tid < 32) cntl[tid] = 0u;
            __syncthreads();
            const int t0 = grp * 128 + wave * 16;
            float myr = 0.f;
            if (lane < 16) { const GAS f32x4* sp = (const GAS f32x4*)(ssq + (size_t)(t0 + lane) * 16); const f32x4 a = sp[0], b = sp[1], c = sp[2], d = sp[3];
                const float tot = (((a[0] + a[1]) + (a[2] + a[3])) + ((b[0] + b[1]) + (b[2] + b[3]))) + (((c[0] + c[1]) + (c[2] + c[3])) + ((d[0] + d[1]) + (d[2] + d[3])));
                myr = __builtin_amdgcn_rsqf(tot * (1.f / DM) + 1e-6f); }
            f32x4 acc0, acc1;
            REPS(62) {
            acc0 = (f32x4){0.f, 0.f, 0.f, 0.f}; acc1 = (f32x4){0.f, 0.f, 0.f, 0.f};
            const bf16* wq = wrh + (size_t)q * 1024 + 8 * g;
            v2u xv[8];
#pragma unroll
            for (int ii = 0; ii < 8; ++ii) xv[ii] = *(const GAS v2u*)(x1b + (size_t)(t0 + 2 * ii + (lane >> 5)) * DM + 4 * (lane & 31));
#pragma unroll 1
            for (int kc = 0; kc < 8; ++kc) {
                const int col = 128 * kc + 4 * (lane & 31);
                const f32x4 gg = *(const GAS f32x4*)(norm_ffn_g + col);
                bf16x8_ bh0[4], bl0[4], bh1[4], bl1[4];
#pragma unroll
                for (int s = 0; s < 4; ++s) { const bf16* p = wq + 128 * kc + 32 * s;
                    bh0[s] = *(const bf16x8_*)p; bh1[s] = *(const bf16x8_*)(p + 16 * 1024); bl0[s] = *(const bf16x8_*)(p + 32 * 1024); bl1[s] = *(const bf16x8_*)(p + 48 * 1024); }
#pragma unroll
                for (int ii = 0; ii < 8; ++ii) { const int i = 2 * ii + (lane >> 5); const float r = __shfl(myr, i);
                    f32x4 v = (f32x4){__uint_as_float(xv[ii].x << 16), __uint_as_float(xv[ii].x & 0xffff0000u), __uint_as_float(xv[ii].y << 16), __uint_as_float(xv[ii].y & 0xffff0000u)} * r * gg;
                    const unsigned h0 = f2bf(v.x), h1 = f2bf(v.y), h2 = f2bf(v.z), h3 = f2bf(v.w);
                    v2u o; o.x = h0 | (h1 << 16); o.y = h2 | (h3 << 16);
                    { int w8 = 0; w8 = __builtin_amdgcn_cvt_pk_fp8_f32(v.x * 4.f, v.y * 4.f, w8, false); w8 = __builtin_amdgcn_cvt_pk_fp8_f32(v.z * 4.f, v.w * 4.f, w8, true);
                      *(GAS int*)((GAS unsigned char*)hn + (size_t)(t0 + i) * DM + col) = w8; }
                    v2u l; l.x = pk2(v.x - __uint_as_float(h0 << 16), v.y - __uint_as_float(h1 << 16)); l.y = pk2(v.z - __uint_as_float(h2 << 16), v.w - __uint_as_float(h3 << 16));
                    *(LAS v2u*)(hnl + i * 272 + 8 * (lane & 31)) = o; *(LAS v2u*)(hnl + 16 * 272 + i * 272 + 8 * (lane & 31)) = l; }
                if (kc < 7) {
#pragma unroll
                    for (int ii = 0; ii < 8; ++ii) xv[ii] = *(const GAS v2u*)(x1b + (size_t)(t0 + 2 * ii + (lane >> 5)) * DM + col + 128);
                }
                LDS_WAIT(); asm volatile("" ::: "memory");
#pragma unroll
                for (int s = 0; s < 4; ++s) {
                    const bf16x8_ ah = *(const LAS bf16x8_*)(hnl + q * 272 + (32 * s + 8 * g) * 2), al = *(const LAS bf16x8_*)(hnl + 16 * 272 + q * 272 + (32 * s + 8 * g) * 2);
                    acc0 = __builtin_amdgcn_mfma_f32_16x16x32_bf16(ah, bh0[s], acc0, 0, 0, 0); acc1 = __builtin_amdgcn_mfma_f32_16x16x32_bf16(ah, bh1[s], acc1, 0, 0, 0);
                    acc0 = __builtin_amdgcn_mfma_f32_16x16x32_bf16(ah, bl0[s], acc0, 0, 0, 0); acc1 = __builtin_amdgcn_mfma_f32_16x16x32_bf16(ah, bl1[s], acc1, 0, 0, 0);
                    acc0 = __builtin_amdgcn_mfma_f32_16x16x32_bf16(al, bh0[s], acc0, 0, 0, 0); acc1 = __builtin_amdgcn_mfma_f32_16x16x32_bf16(al, bh1[s], acc1, 0, 0, 0);
                }
                LDS_WAIT(); asm volatile("" ::: "memory");
            }
            }
            { const float b0 = b_router[q], b1 = b_router[16 + q];
#pragma unroll
              for (int r = 0; r < 4; ++r) { lgl[(4 * g + r) * 32 + q] = acc0[r] + b0; lgl[(4 * g + r) * 32 + 16 + q] = acc1[r] + b1; } }
            LDS_WAIT(); asm volatile("" ::: "memory");
            int pe[4] = {0, 0, 0, 0}; float pg[4] = {0.f, 0.f, 0.f, 0.f}; unsigned prl[4] = {0u, 0u, 0u, 0u};
            if (lane < 16) {
                float lv[32];
#pragma unroll
                for (int e = 0; e < 32; ++e) lv[e] = lgl[lane * 32 + e];
                unsigned used = 0u; float tv[4];
#pragma unroll
                for (int k = 0; k < 4; ++k) { float best = -INFINITY; int bi = 0;
#pragma unroll
                    for (int e = 0; e < 32; ++e) { const bool ok = !((used >> e) & 1u) && lv[e] > best; best = ok ? lv[e] : best; bi = ok ? e : bi; }
                    used |= 1u << bi; pe[k] = bi; tv[k] = best; }
                const float e1 = __expf(tv[1] - tv[0]), e2 = __expf(tv[2] - tv[0]), e3 = __expf(tv[3] - tv[0]); const float inv = 1.f / (1.f + e1 + e2 + e3);
                pg[0] = inv; pg[1] = e1 * inv; pg[2] = e2 * inv; pg[3] = e3 * inv;
#pragma unroll
                for (int k = 0; k < 4; ++k) prl[k] = __hip_atomic_fetch_add(&cntl[pe[k]], 1u, __ATOMIC_RELAXED, __HIP_MEMORY_SCOPE_WORKGROUP);
            }
            __syncthreads();
            if (tid < 32 && fx_) basel[tid] = __hip_atomic_fetch_add(&gcnt[tid], cntl[tid], __ATOMIC_RELAXED, __HIP_MEMORY_SCOPE_AGENT);
            __syncthreads();
            if (lane < 16 && fx_) {
                const int tok = t0 + lane;
#pragma unroll
                for (int k = 0; k < 4; ++k) { const int e = pe[k]; const unsigned rank = basel[e] + prl[k];
                    tokl[(size_t)e * 32768 + rank] = tok; gatek[tok * 4 + k] = pg[k]; pick[tok * 4 + k] = (int)((rank << 5) | (unsigned)e); }
            }
            __syncthreads();
        }
    }
    GRID_BAR();

#endif
#if PHASE_MASK & (1 << 7)
    if (threadIdx.x < 32) {
        const int e = (int)threadIdx.x, n = (int)__hip_atomic_load(&gcnt[e], __ATOMIC_RELAXED, __HIP_MEMORY_SCOPE_AGENT), t = (n + 255) >> 8;
        int cs = t, os = n;
#pragma unroll
        for (int d = 1; d < 32; d <<= 1) { const int a = __shfl_up(cs, d, 32), b2 = __shfl_up(os, d, 32); if (e >= d) { cs += a; os += b2; } }
        cum[e] = cs - t; cntt[e] = n; offt[e] = os - n;
        if (e == 31) { cum[32] = cs; offt[32] = os; } }
    __syncthreads();
    REPS_RT(7) {
        pg8::MoeOrder S{cum, cntt, offt, 8, G, bx, 1024, (const char*)hn, (const char*)wgu_t, (size_t)2048 * 1024, tokl, true, 1};
        pg8::EpiAct E{act, b_gate_up};
        pg8::gemm_phase<pg8::EpiAct, pg8::MoeOrder, true, true>(ldsl, 1024, 1024, S, E, rep_ > 0);
    }
    GRID_BAR();
#endif
#if PHASE_MASK & (1 << 8)
    REPS_RT(8) {
        pg8::MoeOrder S{cum, cntt, offt, 4, G, bx, 1024, (const char*)act, (const char*)wdn_t, (size_t)1024 * 1024, nullptr, false, 1};
        pg8::EpiY E{ybuf, b_down};
        pg8::gemm_phase<pg8::EpiY, pg8::MoeOrder, true, true>(ldsl, 1024, 1024, S, E, rep_ > 0);
    }
    GRID_BAR();

#endif
#if PHASE_MASK & (1 << 9)
    {
        PHASE_IDS
        for (int m = gw; m < T; m += NGW) {
            GAS f32x4* xr = (GAS f32x4*)(out + (size_t)m * DM) + lane;
            f32x4 v[4];
            { const GAS v2u* xb = (const GAS v2u*)(x1b + (size_t)m * DM) + lane; v2u xw[4];
#pragma unroll
              for (int j = 0; j < 4; ++j) xw[j] = xb[64 * j];
#pragma unroll
              for (int j = 0; j < 4; ++j) v[j] = (f32x4){__uint_as_float(xw[j].x << 16), __uint_as_float(xw[j].x & 0xffff0000u), __uint_as_float(xw[j].y << 16), __uint_as_float(xw[j].y & 0xffff0000u)}; }
#pragma unroll
            for (int k = 0; k < 4; ++k) { const int p = __builtin_amdgcn_readfirstlane(pick[m * 4 + k]); const int e = p & 31, rank = (int)((unsigned)p >> 5);
                const float gk = 0.0625f * __uint_as_float((unsigned)__builtin_amdgcn_readfirstlane((int)__float_as_uint(gatek[m * 4 + k])));
                const GAS unsigned* yr = (const GAS unsigned*)((const GAS unsigned char*)ybuf + (size_t)(offt[e] + rank) * DM) + lane;
#pragma unroll
                for (int j = 0; j < 4; ++j) { const int w = (int)yr[64 * j]; typedef float f32x2_ __attribute__((ext_vector_type(2))); const f32x2_ lo = __builtin_amdgcn_cvt_pk_f32_fp8(w, false), hi = __builtin_amdgcn_cvt_pk_f32_fp8(w, true);
                    v[j].x = fmaf(gk, lo.x, v[j].x); v[j].y = fmaf(gk, lo.y, v[j].y); v[j].z = fmaf(gk, hi.x, v[j].z); v[j].w = fmaf(gk, hi.y, v[j].w); } }
            float s = 0.f;
#pragma unroll
            for (int j = 0; j < 4; ++j) s += (v[j].x * v[j].x + v[j].y * v[j].y) + (v[j].z * v[j].z + v[j].w * v[j].w);
            const float rstd = __builtin_amdgcn_rsqf(wave_sum(s) * (1.f / DM) + 1e-6f);
#pragma unroll
            for (int j = 0; j < 4; ++j) { const f32x4 gg = *((const GAS f32x4*)norm_final_g + lane + 64 * j); xr[64 * j] = v[j] * rstd * gg; }
        }
    }
#endif
}

extern "C" void kernel_launch(void* const* d_in, const int* in_sizes, int n_in, void* d_out, int out_size, void* d_ws, size_t ws_size, hipStream_t stream) {
    static int grid = 0;
    if (grid == 0) {
        if (n_in != 20 || in_sizes[0] != T * DM || out_size != T * DM || ws_size < WS_END) { fprintf(stderr, "kernel_launch: unexpected shapes (n_in %d, in0 %d, out %d, ws %zu < %zu); nothing launched\n", n_in, n_in > 0 ? in_sizes[0] : -1, out_size, ws_size, (size_t)WS_END); grid = -1; return; }
        int dev = 0, cus = 0, per_cu = 0;
        if (hipGetDevice(&dev) != hipSuccess || hipDeviceGetAttribute(&cus, hipDeviceAttributeMultiprocessorCount, dev) != hipSuccess) { grid = -1; return; }
        if (hipFuncSetAttribute((const void*)fwd_megakernel, hipFuncAttributeMaxDynamicSharedMemorySize, LDS_BYTES) != hipSuccess) { fprintf(stderr, "kernel_launch: hipFuncSetAttribute failed\n"); grid = -1; return; }
        if (hipOccupancyMaxActiveBlocksPerMultiprocessor(&per_cu, (const void*)fwd_megakernel, NWAVES * 64, LDS_BYTES) != hipSuccess || per_cu < 1) { fprintf(stderr, "kernel_launch: occupancy query says %d\n", per_cu); }
        (void)hipGetLastError();
        grid = cus;
    }
    if (grid < 0) return;
    (void)hipMemsetAsync((char*)d_ws + WS_CTL, 0, CTL_ZERO_BYTES, stream);
    Args a{};
    for (int i = 0; i < 20; ++i) a.in[i] = (const float*)d_in[i];
    a.out = (float*)d_out; a.ws = (unsigned char*)d_ws;
    hipLaunchKernelGGL(fwd_megakernel, dim3(grid), dim3(NWAVES * 64), LDS_BYTES, stream, a);
}
```
